# Optimizing an MI355X kernel written in HIP

```python
import math
import jax
import jax.numpy as jnp
from jax import lax
import numpy as np


D_MODEL = 1024
BATCH = 8
SEQ = 4096
DEPTH = 4

D_MIX = D_MODEL
D_REC = D_MIX // 2
D_SSM = D_MIX - D_REC
REC_HEADS = 8
REC_HEAD_DIM = D_REC // REC_HEADS
CONV_WIDTH = 4
LRU_C = 8.0
SSM_GROUP = 16
SSM_GROUPS = D_SSM // SSM_GROUP
SSM_STATE = 64
N_EXPERT_GROUPS = 4
EXPERTS_PER_GROUP = 8
N_EXPERTS = N_EXPERT_GROUPS * EXPERTS_PER_GROUP
TOP_K = 2
D_EXPERT = D_MODEL // 2
MOE_BLOCK = 128
ALPHA = (2.0 * DEPTH) ** 0.25
BETA = (8.0 * DEPTH) ** -0.25
LN_EPS = 1e-5
RMS_EPS = 1e-6

kernel_name = 'hybrid_rglru_s5_hmoe'


def layer_norm(x, g, b):
    xf = x.astype(jnp.float32)
    mu = jnp.mean(xf, axis=-1, keepdims=True)
    var = jnp.mean(jnp.square(xf - mu), axis=-1, keepdims=True)
    return ((xf - mu) * lax.rsqrt(var + LN_EPS) * g.astype(jnp.float32) + b.astype(jnp.float32)).astype(x.dtype)


def rms_norm(x, g):
    xf = x.astype(jnp.float32)
    return xf * lax.rsqrt(jnp.mean(jnp.square(xf), axis=-1, keepdims=True) + RMS_EPS) * g.astype(jnp.float32)


def causal_depthwise_conv(u, w, b):
    L = u.shape[1]
    up = jnp.pad(u, ((0, 0), (CONV_WIDTH - 1, 0), (0, 0)))
    out = b
    for k in range(CONV_WIDTH):
        out = out + w[k] * up[:, k:k + L]
    return out


def _linear_combine(c1, c2):
    a1, b1 = c1
    a2, b2 = c2
    return a1 * a2, a2 * b1 + b2


def _complex_linear_combine(c1, c2):
    a1r, a1i, b1r, b1i = c1
    a2r, a2i, b2r, b2i = c2
    ar = a1r * a2r - a1i * a2i
    ai = a1r * a2i + a1i * a2r
    br = a2r * b1r - a2i * b1i + b2r
    bi = a2r * b1i + a2i * b1r + b2i
    return ar, ai, br, bi


def rg_lru(u, wa, ba, wx, bx, lam):
    B, L, _ = u.shape
    uf = u.astype(jnp.float32)
    uh = uf.reshape(B, L, REC_HEADS, REC_HEAD_DIM)
    r = jax.nn.sigmoid(jnp.einsum('blhi,hij->blhj', uh, wa.astype(jnp.float32)).reshape(B, L, D_REC) + ba.astype(jnp.float32))
    i = jax.nn.sigmoid(jnp.einsum('blhi,hij->blhj', uh, wx.astype(jnp.float32)).reshape(B, L, D_REC) + bx.astype(jnp.float32))
    log_a = -LRU_C * r * jax.nn.softplus(-lam.astype(jnp.float32))
    a = jnp.exp(log_a)
    mult = jnp.sqrt(-jnp.expm1(2.0 * log_a))
    bterm = mult * (i * uf)
    _, h = lax.associative_scan(_linear_combine, (a, bterm), axis=1)
    return h


def s5_ssm(u, lam_re, lam_im, log_dt, b_re, b_im, c_re, c_im, d_skip, w_glu, b_glu):
    B, L, _ = u.shape
    uf = u.astype(jnp.float32).reshape(B, L, SSM_GROUPS, SSM_GROUP)
    lre = jnp.minimum(lam_re.astype(jnp.float32), -1e-4)
    lim = lam_im.astype(jnp.float32)
    dt = jnp.exp(log_dt.astype(jnp.float32))[:, None]
    mag = jnp.exp(lre * dt)
    abar_re = mag * jnp.cos(lim * dt)
    abar_im = mag * jnp.sin(lim * dt)
    den = lre * lre + lim * lim
    p_re = abar_re - 1.0
    p_im = abar_im
    coef_re = (p_re * lre + p_im * lim) / den
    coef_im = (p_im * lre - p_re * lim) / den
    br = b_re.astype(jnp.float32)
    bi = b_im.astype(jnp.float32)
    bbar_re = coef_re[..., None] * br - coef_im[..., None] * bi
    bbar_im = coef_re[..., None] * bi + coef_im[..., None] * br
    bu_re = jnp.einsum('blgc,gnc->blgn', uf, bbar_re)
    bu_im = jnp.einsum('blgc,gnc->blgn', uf, bbar_im)
    ar = jnp.broadcast_to(abar_re, bu_re.shape)
    ai = jnp.broadcast_to(abar_im, bu_im.shape)
    _, _, xr, xi = lax.associative_scan(_complex_linear_combine, (ar, ai, bu_re, bu_im), axis=1)
    y = (jnp.einsum('blgn,gcn->blgc', xr, c_re.astype(jnp.float32))
         - jnp.einsum('blgn,gcn->blgc', xi, c_im.astype(jnp.float32))
         + d_skip.astype(jnp.float32) * uf)
    y = jax.nn.gelu(y.reshape(B, L, D_SSM))
    z = y @ w_glu.astype(jnp.float32) + b_glu.astype(jnp.float32)
    return z[..., :D_SSM] * jax.nn.sigmoid(z[..., D_SSM:])


def hybrid_mixer(x, w_in, conv_w, conv_b, lru_wa, lru_ba, lru_wx, lru_bx, lru_lambda,
                 ssm_lambda_re, ssm_lambda_im, ssm_log_dt, ssm_b_re, ssm_b_im, ssm_c_re, ssm_c_im,
                 ssm_d, w_glu, b_glu, g_rec, g_ssm, w_out):
    proj = x @ w_in
    gate_br = proj[..., :D_REC]
    rec_br = proj[..., D_REC:2 * D_REC]
    ssm_br = proj[..., 2 * D_REC:]
    rec = causal_depthwise_conv(rec_br, conv_w, conv_b)
    h = rg_lru(rec, lru_wa, lru_ba, lru_wx, lru_bx, lru_lambda)
    y_rec = jax.nn.gelu(gate_br.astype(jnp.float32)) * h
    y_ssm = s5_ssm(ssm_br, ssm_lambda_re, ssm_lambda_im, ssm_log_dt, ssm_b_re, ssm_b_im,
                   ssm_c_re, ssm_c_im, ssm_d, w_glu, b_glu)
    y = jnp.concatenate([rms_norm(y_rec, g_rec), rms_norm(y_ssm, g_ssm)], axis=-1).astype(x.dtype)
    return y @ w_out


def hierarchical_moe(x, router_wg, router_bg, router_we, router_be, exp_w_gate, exp_w_up, exp_w_down):
    B, L, D = x.shape
    T = B * L
    xt = x.reshape(T, D)
    g_prob = jax.nn.softmax((xt @ router_wg).astype(jnp.float32) + router_bg.astype(jnp.float32), axis=-1)
    g_top, g_idx = lax.top_k(g_prob, 1)
    e_logits = ((xt @ router_we).astype(jnp.float32) + router_be.astype(jnp.float32)).reshape(T, N_EXPERT_GROUPS, EXPERTS_PER_GROUP)
    e_in = jnp.take_along_axis(e_logits, g_idx[:, :, None], axis=1)[:, 0]
    e_prob = jax.nn.softmax(e_in, axis=-1)
    e_top, e_idx = lax.top_k(e_prob, TOP_K)
    gates = g_top * e_top / jnp.sum(e_top, axis=-1, keepdims=True)
    expert_id = (g_idx * EXPERTS_PER_GROUP + e_idx).reshape(-1)
    token_id = jnp.repeat(jnp.arange(T, dtype=jnp.int32), TOP_K)
    gate_flat = gates.reshape(-1)
    order = jnp.argsort(expert_id)
    sorted_e = expert_id[order]
    counts = jnp.bincount(expert_id, length=N_EXPERTS)
    starts = jnp.cumsum(counts) - counts
    padded = (counts + MOE_BLOCK - 1) // MOE_BLOCK * MOE_BLOCK
    pad_ends = jnp.cumsum(padded)
    pad_starts = pad_ends - padded
    j = jnp.arange(T * TOP_K, dtype=jnp.int32)
    dest = pad_starts[sorted_e] + j - starts[sorted_e]
    n_blocks = -(-(T * TOP_K) // MOE_BLOCK) + N_EXPERTS
    P = n_blocks * MOE_BLOCK
    buf_tok = jnp.full((P,), T, dtype=jnp.int32).at[dest].set(token_id[order])
    buf_gate = jnp.zeros((P,), jnp.float32).at[dest].set(gate_flat[order])
    block_e = jnp.minimum(jnp.searchsorted(pad_ends, jnp.arange(n_blocks, dtype=jnp.int32) * MOE_BLOCK, side='right'), N_EXPERTS - 1)
    x_pad = jnp.concatenate([xt, jnp.zeros((1, D), xt.dtype)], axis=0)
    xb = x_pad[buf_tok].reshape(n_blocks, MOE_BLOCK, D)

    def expert_block(args):
        xblk, e = args
        hdn = jax.nn.silu(xblk @ exp_w_gate[e]) * (xblk @ exp_w_up[e])
        return hdn @ exp_w_down[e]

    yb = lax.map(expert_block, (xb, block_e)).reshape(P, D)
    y = jax.ops.segment_sum(yb * buf_gate[:, None].astype(yb.dtype), buf_tok, num_segments=T + 1)[:T]
    return y.reshape(B, L, D)


def setup_inputs(seed: int = 0) -> dict:
    key = jax.random.key(seed)
    ks = jax.random.split(key, 40)
    Lc = DEPTH
    f32 = jnp.float32

    def nrm(k, shape, scale):
        return jax.random.normal(k, shape, f32) * scale

    x = nrm(ks[0], (BATCH, SEQ, D_MODEL), 1.0)
    w_in = nrm(ks[1], (Lc, D_MODEL, 2 * D_REC + D_SSM), D_MODEL ** -0.5)
    conv_w = nrm(ks[2], (Lc, CONV_WIDTH, D_REC), CONV_WIDTH ** -0.5)
    conv_b = nrm(ks[3], (Lc, D_REC), 0.01)
    lru_wa = nrm(ks[4], (Lc, REC_HEADS, REC_HEAD_DIM, REC_HEAD_DIM), REC_HEAD_DIM ** -0.5)
    lru_ba = nrm(ks[5], (Lc, D_REC), 0.01)
    lru_wx = nrm(ks[6], (Lc, REC_HEADS, REC_HEAD_DIM, REC_HEAD_DIM), REC_HEAD_DIM ** -0.5)
    lru_bx = nrm(ks[7], (Lc, D_REC), 0.01)
    a0 = jax.random.uniform(ks[8], (Lc, D_REC), f32, minval=0.9, maxval=0.999)
    lru_lambda = jnp.log(a0) - jnp.log1p(-a0)
    n_idx = jnp.arange(SSM_STATE, dtype=f32)
    ssm_lambda_re = -0.5 + nrm(ks[9], (Lc, SSM_GROUPS, SSM_STATE), 0.01)
    ssm_lambda_im = jnp.pi * n_idx + nrm(ks[10], (Lc, SSM_GROUPS, SSM_STATE), 0.01)
    ssm_log_dt = jax.random.uniform(ks[11], (Lc, SSM_GROUPS), f32, minval=math.log(1e-3), maxval=math.log(1e-1))
    ssm_b_re = nrm(ks[12], (Lc, SSM_GROUPS, SSM_STATE, SSM_GROUP), (2.0 * SSM_GROUP) ** -0.5)
    ssm_b_im = nrm(ks[13], (Lc, SSM_GROUPS, SSM_STATE, SSM_GROUP), (2.0 * SSM_GROUP) ** -0.5)
    ssm_c_re = nrm(ks[14], (Lc, SSM_GROUPS, SSM_GROUP, SSM_STATE), SSM_STATE ** -0.5)
    ssm_c_im = nrm(ks[15], (Lc, SSM_GROUPS, SSM_GROUP, SSM_STATE), SSM_STATE ** -0.5)
    ssm_d = nrm(ks[16], (Lc, SSM_GROUPS, SSM_GROUP), 1.0)
    w_glu = nrm(ks[17], (Lc, D_SSM, 2 * D_SSM), D_SSM ** -0.5)
    b_glu = nrm(ks[18], (Lc, 2 * D_SSM), 0.01)
    g_rec = 1.0 + nrm(ks[19], (Lc, D_REC), 0.01)
    g_ssm = 1.0 + nrm(ks[20], (Lc, D_SSM), 0.01)
    w_out = nrm(ks[21], (Lc, D_MIX, D_MODEL), (D_MIX ** -0.5) * BETA)
    ln1_g = 1.0 + nrm(ks[22], (Lc, D_MODEL), 0.01)
    ln1_b = nrm(ks[23], (Lc, D_MODEL), 0.01)
    router_wg = nrm(ks[24], (Lc, D_MODEL, N_EXPERT_GROUPS), D_MODEL ** -0.5)
    router_bg = nrm(ks[25], (Lc, N_EXPERT_GROUPS), 0.01)
    router_we = nrm(ks[26], (Lc, D_MODEL, N_EXPERTS), D_MODEL ** -0.5)
    router_be = nrm(ks[27], (Lc, N_EXPERTS), 0.01)
    exp_w_gate = nrm(ks[28], (Lc, N_EXPERTS, D_MODEL, D_EXPERT), D_MODEL ** -0.5)
    exp_w_up = nrm(ks[29], (Lc, N_EXPERTS, D_MODEL, D_EXPERT), D_MODEL ** -0.5)
    exp_w_down = nrm(ks[30], (Lc, N_EXPERTS, D_EXPERT, D_MODEL), (D_EXPERT ** -0.5) * BETA)
    ln2_g = 1.0 + nrm(ks[31], (Lc, D_MODEL), 0.01)
    ln2_b = nrm(ks[32], (Lc, D_MODEL), 0.01)
    return {'x': x, 'w_in': w_in, 'conv_w': conv_w, 'conv_b': conv_b,
            'lru_wa': lru_wa, 'lru_ba': lru_ba, 'lru_wx': lru_wx, 'lru_bx': lru_bx, 'lru_lambda': lru_lambda,
            'ssm_lambda_re': ssm_lambda_re, 'ssm_lambda_im': ssm_lambda_im, 'ssm_log_dt': ssm_log_dt,
            'ssm_b_re': ssm_b_re, 'ssm_b_im': ssm_b_im, 'ssm_c_re': ssm_c_re, 'ssm_c_im': ssm_c_im,
            'ssm_d': ssm_d, 'w_glu': w_glu, 'b_glu': b_glu, 'g_rec': g_rec, 'g_ssm': g_ssm,
            'w_out': w_out, 'ln1_g': ln1_g, 'ln1_b': ln1_b,
            'router_wg': router_wg, 'router_bg': router_bg, 'router_we': router_we, 'router_be': router_be,
            'exp_w_gate': exp_w_gate, 'exp_w_up': exp_w_up, 'exp_w_down': exp_w_down,
            'ln2_g': ln2_g, 'ln2_b': ln2_b}


def reference(x, w_in, conv_w, conv_b, lru_wa, lru_ba, lru_wx, lru_bx, lru_lambda,
              ssm_lambda_re, ssm_lambda_im, ssm_log_dt, ssm_b_re, ssm_b_im, ssm_c_re, ssm_c_im,
              ssm_d, w_glu, b_glu, g_rec, g_ssm, w_out, ln1_g, ln1_b,
              router_wg, router_bg, router_we, router_be, exp_w_gate, exp_w_up, exp_w_down,
              ln2_g, ln2_b):
    for l in range(DEPTH):
        mix = hybrid_mixer(x, w_in[l], conv_w[l], conv_b[l], lru_wa[l], lru_ba[l], lru_wx[l], lru_bx[l],
                           lru_lambda[l], ssm_lambda_re[l], ssm_lambda_im[l], ssm_log_dt[l],
                           ssm_b_re[l], ssm_b_im[l], ssm_c_re[l], ssm_c_im[l], ssm_d[l],
                           w_glu[l], b_glu[l], g_rec[l], g_ssm[l], w_out[l])
        x = layer_norm(ALPHA * x + mix, ln1_g[l], ln1_b[l])
        ff = hierarchical_moe(x, router_wg[l], router_bg[l], router_we[l], router_be[l],
                              exp_w_gate[l], exp_w_up[l], exp_w_down[l])
        x = layer_norm(ALPHA * x + ff, ln2_g[l], ln2_b[l])
    return x
```

```cpp
#include <hip/hip_runtime.h>
#include <cstdio>
#include <cstdint>

typedef unsigned short bf16;
#define LAS __attribute__((address_space(3)))

constexpr int BATCH = 8, SEQ = 4096, D = 1024, T = BATCH * SEQ, DEPTH = 4;
constexpr int DREC = 512, DSSM = 512, NH = 8, HD = 64, NGRP = 32, GC = 16, NST = 64;
constexpr int NEG = 4, EPG = 8, NE = 32, DE = 512, NPROJ = 1536;
constexpr float ALPHA = 1.681792830507429f;
constexpr float LN_EPS = 1e-5f, RMS_EPS = 1e-6f;
constexpr int NWAVES = 8, NTHREADS = 512;
constexpr int DUPMASK = 0x0;

constexpr size_t MiB = 1u << 20;
constexpr size_t WS_CTL = 0, CTL_ZERO_BYTES = 128 * 1024;
constexpr size_t WS_WIN = 1 * MiB;
constexpr size_t WS_WGLU = WS_WIN + (size_t)DEPTH * NPROJ * D * 2;
constexpr size_t WS_WOUT = WS_WGLU + (size_t)DEPTH * 1024 * 512 * 2;
constexpr size_t WS_WGU = WS_WOUT + (size_t)DEPTH * 1024 * 1024 * 2;
constexpr size_t WS_WD = WS_WGU + (size_t)DEPTH * NE * 1024 * 1024 * 2;
constexpr size_t WS_A16 = WS_WD + (size_t)DEPTH * NE * 1024 * 512 * 2;
constexpr size_t WS_WRT = WS_A16 + 1 * MiB;
constexpr size_t WS_RC = WS_WRT + 512 * 1024;
constexpr size_t WS_B16 = WS_WRT + 1 * MiB;
constexpr size_t WS_WS5 = WS_B16 + 8 * MiB;
constexpr size_t WS_WGT = WS_WS5 + 24 * MiB;
constexpr size_t WS_GB = WS_WGT + 2 * MiB;
constexpr size_t WS_XB = WS_GB + 1 * MiB;
constexpr size_t WS_EID = WS_XB + (size_t)T * D * 2;
constexpr size_t WS_GATE = WS_EID + (size_t)T * 2 * 4, WS_LIST = WS_GATE + (size_t)NE * T * 4;
constexpr size_t WS_ACT = WS_LIST + (size_t)NE * T * 4;
constexpr size_t WS_PROJ = WS_ACT;
constexpr size_t WS_YS = WS_PROJ + (size_t)T * NPROJ * 2;
constexpr size_t WS_YREC = WS_YS + (size_t)T * 512 * 2;
constexpr size_t WS_UG = WS_YREC + (size_t)T * 512 * 2;
constexpr size_t WS_YCAT = WS_UG + (size_t)T * 512 * 2;
constexpr size_t WS_ACT_END1 = WS_YCAT + (size_t)T * 1024 * 2;
constexpr int MAXTILES = 2 * T / 256 + NE;
constexpr size_t WS_H = WS_ACT;
constexpr size_t WS_Y = WS_H + (size_t)MAXTILES * 256 * 512 * 2;
constexpr size_t WS_ACT_END2 = WS_Y + (size_t)2 * T * 1024 * 2;
constexpr size_t WS_END = WS_ACT_END1 > WS_ACT_END2 ? WS_ACT_END1 : WS_ACT_END2;
constexpr int CW_CNT = 1024;
constexpr int CW_BAR = 16384;
constexpr int XCD_BAR_WORDS_C = 3456, MAX_LAUNCHES = 1;
static_assert((CW_BAR + MAX_LAUNCHES * XCD_BAR_WORDS_C) * 4 <= (int)CTL_ZERO_BYTES, "ctl");
constexpr int LDS_CTL = 0, LDS_RING = 4096, LDS_BYTES = 147456;
constexpr int LC_BAR = 0, LC_TB = 64, LC_CN = 256, LC_LCNT = 384, LC_GB = 512, LC_ENT = 1024, LC_RANK = 2048, LC_GV = 3072;

typedef __bf16 bf16x2_t __attribute__((ext_vector_type(2)));
typedef float f32x2_t __attribute__((ext_vector_type(2)));
__device__ __forceinline__ unsigned pk2(float lo, float hi) { const f32x2_t v = {lo, hi}; const bf16x2_t b = __builtin_convertvector(v, bf16x2_t); return __builtin_bit_cast(unsigned, b); }
__device__ __forceinline__ bf16 f2bf(float f) { return (bf16)(pk2(f, 0.f) & 0xffffu); }
__device__ __forceinline__ float bf2f(bf16 h) { return __uint_as_float(((unsigned)h) << 16); }
__device__ __forceinline__ float bflo(unsigned u) { return __uint_as_float(u << 16); }
__device__ __forceinline__ float bfhi(unsigned u) { return __uint_as_float(u & 0xffff0000u); }
__device__ __forceinline__ float gelu_tanh(float x) { return 0.5f * x * (1.f + tanhf(0.7978845608028654f * (x + 0.044715f * x * x * x))); }
__device__ __forceinline__ float gelu_fast(float x) { return x * __builtin_amdgcn_rcpf(1.f + __expf(-1.5957691216057308f * (x + 0.044715f * x * x * x))); }
__device__ __forceinline__ float sigmoidf(float x) { return __builtin_amdgcn_rcpf(1.f + __expf(-x)); }
__device__ __forceinline__ float lane_get(float v, int src_lane) { return __int_as_float(__builtin_amdgcn_ds_bpermute(src_lane << 2, __float_as_int(v))); }
template <int CTRL> __device__ __forceinline__ float dppf(float v) { return __int_as_float(__builtin_amdgcn_update_dpp(0, __float_as_int(v), CTRL, 0xF, 0xF, true)); }
__device__ __forceinline__ float row16_sum(float s) { s += dppf<0xB1>(s); s += dppf<0x4E>(s); s += dppf<0x141>(s); s += dppf<0x140>(s); return s; }
__device__ __forceinline__ float wave_sum(float v, int) {
    v = row16_sum(v);
    const float a = __int_as_float(__builtin_amdgcn_readlane(__float_as_int(v), 0)), b = __int_as_float(__builtin_amdgcn_readlane(__float_as_int(v), 16));
    const float c = __int_as_float(__builtin_amdgcn_readlane(__float_as_int(v), 32)), d = __int_as_float(__builtin_amdgcn_readlane(__float_as_int(v), 48));
    return (a + b) + (c + d); }


namespace pg8 {
#define PG8_LAS __attribute__((address_space(3)))
typedef unsigned short bf16_t;
typedef short bf16x8 __attribute__((ext_vector_type(8)));
typedef float f32x4 __attribute__((ext_vector_type(4)));
typedef unsigned u32x4 __attribute__((ext_vector_type(4)));
typedef unsigned u32x2 __attribute__((ext_vector_type(2)));
constexpr int BM = 256, BK = 64, HALF = 128, HTB = HALF * BK * 2, STAGE_BYTES = 8 * HTB, NXCD = 8, WGM = 8;

__host__ __device__ __forceinline__ int lds_byte(int r, int c) { const int st = (r >> 4) * 2 + (c >> 5), rr = r & 15, cc = c & 31, ob = rr * 64 + cc * 2; return st * 1024 + (ob ^ (((ob >> 9) & 1) << 5)); }
__host__ __device__ __forceinline__ void stage_rc(int b, int& R, int& C) { const int st = b / 1024, sb = b % 1024, swz = sb ^ (((sb >> 9) & 1) << 5); R = (st >> 1) * 16 + swz / 64; C = (st & 1) * 32 + (swz % 64) / 2; }
__host__ __device__ __forceinline__ int perm32(int rho) { const int n = rho >> 4, i = rho & 15; return 8 * (i >> 2) + 4 * n + (i & 3); }

struct Unit { int pm, pn, e, s0; long bo; };
struct Gemm { const bf16_t* A; const bf16_t* Bt; int M, N, K; };

struct StaticOrder {
    int nM, nN, nwg, G, c; long tstep;
    __device__ void init(int M, int N, int K, int G_, int c_) { nM = M / BM; nN = N / BM; nwg = nM * nN; G = G_; c = c_; tstep = (long)BM * K * 2; }
    __device__ bool next(int i, Unit& u) const {
        const long L = (long)i * G + c; if (L >= nwg) return false;
        int wgid = (int)L; { const int q = nwg / NXCD, r = nwg % NXCD, xcd = wgid % NXCD, off = wgid / NXCD; wgid = (xcd < r ? xcd * (q + 1) : r * (q + 1) + (xcd - r) * q) + off; }
        const int nig = WGM * nN, gid = wgid / nig, fm = gid * WGM, gsz = (nM - fm) < WGM ? (nM - fm) : WGM;
        u.pm = fm + ((wgid % nig) % gsz); u.pn = (wgid % nig) / gsz; u.e = 0; u.s0 = 0; u.bo = (long)u.pn * tstep; return true;
    }
    __device__ __forceinline__ unsigned a_off(const Unit&, int, int, int) const { return 0u; }
};
struct MoeOrder {
    const PG8_LAS int* tb; const PG8_LAS unsigned* cn; const int* list; int G, c, K; long estride, tstep; int lane; PG8_LAS unsigned char* gb;
    __device__ bool next(int i, Unit& u) const {
        const int U = tb[NE] * 4; int cc = c;
        if ((i + 1) * G > U && G == 256) cc = (c & 7) * 32 + (c >> 3);
        const int L = i * G + cc, tt = L >> 2; if (L >= U) return false;
        const int tbl = (lane >= 1 && lane < NE) ? tb[lane] : 0x7fffffff;
        const int e = __builtin_popcountll(__builtin_amdgcn_ballot_w64(tt >= tbl));
        u.pm = tt; u.pn = L & 3; u.e = e; u.s0 = (tt - tb[e]) * BM; u.bo = (long)e * estride + (long)u.pn * tstep; return true;
    }
    __device__ __forceinline__ void stage_list(const Unit& u, int slot, int wid, int lane_) const {
        if (wid == 0) __builtin_amdgcn_global_load_lds((const unsigned*)(list + (size_t)u.e * T + u.s0 + 4 * lane_), (PG8_LAS unsigned*)(gb + slot * 1024), 16, 0, 0);
    }
    __device__ __forceinline__ unsigned a_off_lds(const Unit& u, int slot, int h, int R, int C) const {
        const unsigned s = (unsigned)(u.s0 + h * HALF + R); int tok = 0;
        if (s < cn[u.e]) tok = ((const PG8_LAS int*)(gb + slot * 1024))[h * HALF + R] >> 1;
        return (unsigned)tok * (unsigned)(K * 2) + (unsigned)(C * 2);
    }
    __device__ __forceinline__ unsigned a_off(const Unit& u, int h, int R, int C) const {
        const unsigned s = (unsigned)(u.s0 + h * HALF + R); int tok = 0;
        if (s < cn[u.e]) tok = list[(size_t)u.e * T + s] >> 1;
        return (unsigned)tok * (unsigned)(K * 2) + (unsigned)(C * 2);
    }
};

struct EpiProj {
    static constexpr bool PERM = true, MID = false, PRE = false;
    bf16_t* O;
    __device__ __forceinline__ void operator()(const f32x4 (&acc)[2][2][4][2], const Unit& u, int ui, int wr, int wc, int fr, int fq) const {
        const int row0 = u.pm * BM + wr * 64 + fr, sec = u.pn >> 1;
#pragma unroll
        for (int bj = 0; bj < 2; ++bj) { const int cc = (u.pn & 1) * BM + bj * HALF + wc * 32 + 8 * fq;
#pragma unroll
            for (int ai = 0; ai < 2; ++ai)
#pragma unroll
                for (int m = 0; m < 4; ++m) { const int row = row0 + ai * HALF + m * 16, b = row >> 12, t = row & 4095;
                    const size_t off = (sec == 1) ? ((size_t)((b * 8 + (cc >> 6)) * 4096 + t) * 64 + (cc & 63)) : ((size_t)((b * 32 + (cc >> 4)) * 4096 + t) * 16 + (cc & 15));
                    f32x4 v0 = acc[ai][bj][m][0], v1 = acc[ai][bj][m][1];
                    if (sec == 0) {
#pragma unroll
                        for (int i = 0; i < 4; ++i) { v0[i] = gelu_fast(v0[i]); v1[i] = gelu_fast(v1[i]); } }
                    u32x4 w; w.x = pk2(v0[0], v0[1]); w.y = pk2(v0[2], v0[3]); w.z = pk2(v1[0], v1[1]); w.w = pk2(v1[2], v1[3]);
                    *(u32x4*)(O + (size_t)sec * ((size_t)T * 512) + off) = w; } }
    }
};
struct EpiStoreBf16 {
    static constexpr bool PERM = true, MID = false, PRE = false;
    bf16_t* O; int ldc;
    __device__ __forceinline__ void operator()(const f32x4 (&acc)[2][2][4][2], const Unit& u, int ui, int wr, int wc, int fr, int fq) const {
        const int row0 = u.pm * BM + wr * 64 + fr, col0 = u.pn * BM + wc * 32 + 8 * fq;
#pragma unroll
        for (int ai = 0; ai < 2; ++ai)
#pragma unroll
            for (int m = 0; m < 4; ++m) { bf16_t* rowp = O + (size_t)(row0 + ai * HALF + m * 16) * ldc + col0;
#pragma unroll
                for (int bj = 0; bj < 2; ++bj) { const f32x4 v0 = acc[ai][bj][m][0], v1 = acc[ai][bj][m][1];
                    u32x4 w; w.x = pk2(v0[0], v0[1]); w.y = pk2(v0[2], v0[3]); w.z = pk2(v1[0], v1[1]); w.w = pk2(v1[2], v1[3]);
                    *(u32x4*)(rowp + bj * HALF) = w; } }
    }
};
template <int MODE> struct EpiGated {
    static constexpr bool PERM = true, MID = false, PRE = false;
    bf16_t* O; const float* bias; int ldo; float* ssp;
    __device__ __forceinline__ void operator()(const f32x4 (&acc)[2][2][4][2], const Unit& u, int ui, int wr, int wc, int fr, int fq) const {
        const int row0 = u.pm * BM + wr * 64 + fr, oc0 = u.pn * HALF + wc * 32 + 8 * fq;
        f32x4 bvv[2] = {{0.f, 0.f, 0.f, 0.f}, {0.f, 0.f, 0.f, 0.f}}, bgg[2] = {{0.f, 0.f, 0.f, 0.f}, {0.f, 0.f, 0.f, 0.f}};
        if (MODE == 0) {
#pragma unroll
            for (int bj = 0; bj < 2; ++bj) { bvv[bj] = *(const f32x4*)(bias + oc0 + 4 * bj); bgg[bj] = *(const f32x4*)(bias + 512 + oc0 + 4 * bj); } }
        float ssr[2][4] = {{0.f, 0.f, 0.f, 0.f}, {0.f, 0.f, 0.f, 0.f}};
#pragma unroll
        for (int ai = 0; ai < 2; ++ai)
#pragma unroll
            for (int m = 0; m < 4; ++m) { float o[2][4];
#pragma unroll
                for (int bj = 0; bj < 2; ++bj) { const f32x4 a = acc[ai][bj][m][0], b = acc[ai][bj][m][1], bv = bvv[bj], bg = bgg[bj];
#pragma unroll
                    for (int i = 0; i < 4; ++i) { if (MODE == 0) o[bj][i] = (a[i] + bv[i]) * sigmoidf(b[i] + bg[i]); else o[bj][i] = a[i] * sigmoidf(a[i]) * b[i]; }
                    if (MODE == 0) ssr[ai][m] += o[bj][0] * o[bj][0] + o[bj][1] * o[bj][1] + o[bj][2] * o[bj][2] + o[bj][3] * o[bj][3]; }
                u32x4 w; w.x = pk2(o[0][0], o[0][1]); w.y = pk2(o[0][2], o[0][3]); w.z = pk2(o[1][0], o[1][1]); w.w = pk2(o[1][2], o[1][3]);
                *(u32x4*)(O + (size_t)(row0 + ai * HALF + m * 16) * ldo + oc0) = w; }
        if (MODE == 0) { int ln = fr + 16 * fq; asm volatile("" : "+v"(ln));
#pragma unroll
            for (int ai = 0; ai < 2; ++ai)
#pragma unroll
                for (int m = 0; m < 4; ++m) { float sq = ssr[ai][m]; sq += lane_get(sq, ln ^ 16); sq += lane_get(sq, ln ^ 32);
                    if (fq == 0) ssp[(size_t)(row0 + ai * HALF + m * 16) * 16 + u.pn * 4 + wc] = sq; } }
    }
};
struct EpiResidBf16 {
    static constexpr bool PERM = true, MID = false, PRE = false;
    bf16_t* X;
    __device__ __forceinline__ void operator()(const f32x4 (&acc)[2][2][4][2], const Unit& u, int ui, int wr, int wc, int fr, int fq) const {
        const int row0 = u.pm * BM + wr * 64 + fr, col0 = u.pn * BM + wc * 32 + 8 * fq;
        u32x4 o[2][4][2];
#pragma unroll
        for (int ai = 0; ai < 2; ++ai)
#pragma unroll
            for (int m = 0; m < 4; ++m)
#pragma unroll
                for (int bj = 0; bj < 2; ++bj) o[ai][m][bj] = *(const u32x4*)(X + (size_t)(row0 + ai * HALF + m * 16) * D + col0 + bj * HALF);
#pragma unroll
        for (int ai = 0; ai < 2; ++ai)
#pragma unroll
            for (int m = 0; m < 4; ++m) { bf16_t* rowp = X + (size_t)(row0 + ai * HALF + m * 16) * D + col0;
#pragma unroll
                for (int bj = 0; bj < 2; ++bj) { const u32x4 ov = o[ai][m][bj]; const f32x4 v0 = acc[ai][bj][m][0], v1 = acc[ai][bj][m][1];
                    u32x4 w; w.x = pk2(ALPHA * bflo(ov.x) + v0[0], ALPHA * bfhi(ov.x) + v0[1]); w.y = pk2(ALPHA * bflo(ov.y) + v0[2], ALPHA * bfhi(ov.y) + v0[3]);
                    w.z = pk2(ALPHA * bflo(ov.z) + v1[0], ALPHA * bfhi(ov.z) + v1[1]); w.w = pk2(ALPHA * bflo(ov.w) + v1[2], ALPHA * bfhi(ov.w) + v1[3]);
                    *(u32x4*)(rowp + bj * HALF) = w; } }
    }
};
struct EpiResidRms {
    static constexpr bool PERM = true, MID = true, PRE = false;
    bf16_t* X; const PG8_LAS float* st;
    __device__ __forceinline__ void mid(f32x4 (&acc)[2][2][4][2], int ui, int wr, int fr) const {
#pragma unroll
        for (int ai = 0; ai < 2; ++ai)
#pragma unroll
            for (int m = 0; m < 4; ++m) { const float s = st[(ui * BM + ai * HALF + wr * 64 + m * 16 + fr) * 2];
#pragma unroll
                for (int bj = 0; bj < 2; ++bj)
#pragma unroll
                    for (int n = 0; n < 2; ++n) acc[ai][bj][m][n] *= s; }
    }
    __device__ __forceinline__ void operator()(const f32x4 (&acc)[2][2][4][2], const Unit& u, int ui, int wr, int wc, int fr, int fq) const {
        const int row0 = u.pm * BM + wr * 64 + fr, col0 = u.pn * BM + wc * 32 + 8 * fq;
        u32x4 o[2][4][2]; float sc[2][4];
#pragma unroll
        for (int ai = 0; ai < 2; ++ai)
#pragma unroll
            for (int m = 0; m < 4; ++m) { sc[ai][m] = st[(ui * BM + ai * HALF + wr * 64 + m * 16 + fr) * 2 + 1];
#pragma unroll
                for (int bj = 0; bj < 2; ++bj) o[ai][m][bj] = *(const u32x4*)(X + (size_t)(row0 + ai * HALF + m * 16) * D + col0 + bj * HALF); }
#pragma unroll
        for (int ai = 0; ai < 2; ++ai)
#pragma unroll
            for (int m = 0; m < 4; ++m) { bf16_t* rowp = X + (size_t)(row0 + ai * HALF + m * 16) * D + col0; const float s = sc[ai][m];
#pragma unroll
                for (int bj = 0; bj < 2; ++bj) { const u32x4 ov = o[ai][m][bj]; const f32x4 v0 = acc[ai][bj][m][0] * s, v1 = acc[ai][bj][m][1] * s;
                    u32x4 w; w.x = pk2(ALPHA * bflo(ov.x) + v0[0], ALPHA * bfhi(ov.x) + v0[1]); w.y = pk2(ALPHA * bflo(ov.y) + v0[2], ALPHA * bfhi(ov.y) + v0[3]);
                    w.z = pk2(ALPHA * bflo(ov.z) + v1[0], ALPHA * bfhi(ov.z) + v1[1]); w.w = pk2(ALPHA * bflo(ov.w) + v1[2], ALPHA * bfhi(ov.w) + v1[3]);
                    *(u32x4*)(rowp + bj * HALF) = w; } }
    }
};
struct EpiMoeOut {
    static constexpr bool PERM = true, MID = false, PRE = true;
    bf16_t* Y; const int* list; const float* gate; const PG8_LAS unsigned* cn; PG8_LAS unsigned char* lb;
    __device__ __forceinline__ void unit_begin(const Unit& u, int ui, int wid, int lane) const {
        if (wid == 0) { const size_t off = (size_t)u.e * T + u.s0 + 4 * lane;
            __builtin_amdgcn_global_load_lds((const unsigned*)(list + off), (PG8_LAS unsigned*)(lb + (ui & 1) * 2048), 16, 0, 0);
            __builtin_amdgcn_global_load_lds((const unsigned*)(gate + off), (PG8_LAS unsigned*)(lb + (ui & 1) * 2048 + 1024), 16, 0, 0); }
    }
    __device__ __forceinline__ void operator()(const f32x4 (&acc)[2][2][4][2], const Unit& u, int ui, int wr, int wc, int fr, int fq) const {
        const int col0 = u.pn * BM + wc * 64 + 8 * fq;
        const unsigned n = cn[u.e];
        const PG8_LAS int* ll = (const PG8_LAS int*)(lb + (ui & 1) * 2048); const PG8_LAS float* gl = (const PG8_LAS float*)(lb + (ui & 1) * 2048 + 1024);
        int dest[2][4]; float gt[2][4];
#pragma unroll
        for (int ai = 0; ai < 2; ++ai)
#pragma unroll
            for (int m = 0; m < 4; ++m) { const int sl = ai * HALF + wr * 64 + m * 16 + fr; const bool ok = (unsigned)(u.s0 + sl) < n;
                dest[ai][m] = ok ? ll[sl] : -1; gt[ai][m] = ok ? gl[sl] : 0.f; }
#pragma unroll
        for (int ai = 0; ai < 2; ++ai)
#pragma unroll
            for (int m = 0; m < 4; ++m) {
                if (dest[ai][m] >= 0) { bf16_t* rowp = Y + (size_t)dest[ai][m] * D + col0; const float g_ = gt[ai][m];
#pragma unroll
                    for (int bj = 0; bj < 2; ++bj) { const f32x4 v0 = acc[ai][bj][m][0] * g_, v1 = acc[ai][bj][m][1] * g_;
                        u32x4 w; w.x = pk2(v0[0], v0[1]); w.y = pk2(v0[2], v0[3]); w.z = pk2(v1[0], v1[1]); w.w = pk2(v1[2], v1[3]);
                        *(u32x4*)(rowp + bj * 32) = w; } } }
    }
};

#ifndef PG8_ALIGN_EPI
#define PG8_ALIGN_EPI 1
#endif
template <class Epi, class Sched, bool GATHER>
__device__ __forceinline__ void gemm_phase(PG8_LAS unsigned char* lds, const Gemm g, const Sched& S, const Epi& E, int tid_in) {
    int tid_ = tid_in; asm volatile("" : "+v"(tid_));
    const int tid = tid_, wid = __builtin_amdgcn_readfirstlane(tid >> 6), lane = tid & 63, wr = wid >> 2, wc = wid & 3, fr = lane & 15, fq = lane >> 4;
    const int K = g.K, nt = K / BK;
    unsigned voffA[2], voffB[2]; int RA[2], CA[2];
#pragma unroll
    for (int i = 0; i < 2; ++i) { int R, C; stage_rc(tid * 16 + i * 8192, R, C); const int Rb = Epi::PERM ? ((R & ~31) + perm32(R & 31)) : R;
        voffA[i] = (unsigned)(R * K + C) * 2u; voffB[i] = (unsigned)(Rb * K + C) * 2u; RA[i] = R; CA[i] = C; }
    const size_t kstep = (size_t)(BK * 2);
    const size_t hstep = (size_t)HALF * K * 2;
    const size_t tstep = 2 * hstep;
    const unsigned ldsw = (unsigned)wid * 1024u;
    const int aoff = lds_byte(wr * 64 + fr, fq * 8), boff = lds_byte(wc * 32 + fr, fq * 8);
#define PG8_SA(b, h) (((b) * 2 + (h)) * HTB)
#define PG8_SB(b, h) ((4 + (b) * 2 + (h)) * HTB)
#define PG8_STAGE(bufoff, gbase, voff) do { _Pragma("unroll") for (int _i = 0; _i < 2; ++_i) \
        __builtin_amdgcn_global_load_lds((const unsigned*)((const char*)(gbase) + (voff)[_i]), (PG8_LAS unsigned*)(lds + (bufoff) + ldsw + _i * 8192), 16, 0, 0); } while (0)
#define PG8_STAGE_A(bufoff, abase, h, vg) do { if constexpr (GATHER) { PG8_STAGE(bufoff, abase, vg[h]); } else { PG8_STAGE(bufoff, (abase) + (h) * hstep, voffA); } } while (0)
#define PG8_LDA(dst, b, h) do { _Pragma("unroll") for (int m = 0; m < 4; ++m) _Pragma("unroll") for (int k = 0; k < 2; ++k) dst[m][k] = *(const PG8_LAS bf16x8*)(lds + PG8_SA(b, h) + aoff + m * 2048 + k * 1024); } while (0)
#define PG8_LDB(dst, b, h) do { _Pragma("unroll") for (int n = 0; n < 2; ++n) _Pragma("unroll") for (int k = 0; k < 2; ++k) dst[n][k] = *(const PG8_LAS bf16x8*)(lds + PG8_SB(b, h) + boff + n * 2048 + k * 1024); } while (0)
#define PG8_MMA(ai, bj, At, Bt) do { __builtin_amdgcn_s_setprio(1); _Pragma("unroll") for (int m = 0; m < 4; ++m) _Pragma("unroll") for (int n = 0; n < 2; ++n) _Pragma("unroll") for (int k = 0; k < 2; ++k) \
        acc[ai][bj][m][n] = __builtin_amdgcn_mfma_f32_16x16x32_bf16(Bt[n][k], At[m][k], acc[ai][bj][m][n], 0, 0, 0); __builtin_amdgcn_s_setprio(0); } while (0)
#define PG8_WAIT_V(n) asm volatile("s_waitcnt vmcnt(" #n ")" ::: "memory")
#define PG8_WAIT_L(n) asm volatile("s_waitcnt lgkmcnt(" #n ")" ::: "memory")
#define PG8_BAR __builtin_amdgcn_s_barrier()
#define PG8_SCHED __builtin_amdgcn_sched_barrier(0)
    Unit cur, nxt, nn; int ui = 0;
    if (!S.next(0, cur)) return;
    bool has_next = S.next(1, nxt);
    f32x4 acc[2][2][4][2];
#pragma unroll
    for (int a = 0; a < 2; ++a)
#pragma unroll
        for (int b = 0; b < 2; ++b)
#pragma unroll
            for (int m = 0; m < 4; ++m)
#pragma unroll
                for (int n = 0; n < 2; ++n) acc[a][b][m][n] = (f32x4){0.f, 0.f, 0.f, 0.f};
    bf16x8 At[4][2], B0[2][2], B1[2][2];
    unsigned vgC[2][2] = {{0u, 0u}, {0u, 0u}}, vgN[2][2] = {{0u, 0u}, {0u, 0u}};
    if constexpr (GATHER) {
#pragma unroll
        for (int h = 0; h < 2; ++h)
#pragma unroll
            for (int i = 0; i < 2; ++i) vgC[h][i] = S.a_off(cur, h, RA[i], CA[i]);
        if (has_next) S.stage_list(nxt, 1, wid, lane);
    }
    const char* cA = GATHER ? (const char*)g.A : (const char*)g.A + (size_t)cur.pm * tstep; const char* cB = (const char*)g.Bt + cur.bo;
    PG8_STAGE(PG8_SB(0, 0), cB, voffB); PG8_STAGE(PG8_SB(0, 1), cB + hstep, voffB); PG8_STAGE_A(PG8_SA(0, 0), cA, 0, vgC); PG8_STAGE_A(PG8_SA(0, 1), cA, 1, vgC);
    if (wr == 1) PG8_BAR;
    PG8_WAIT_V(2); PG8_BAR;
    PG8_STAGE(PG8_SB(1, 0), cB + kstep, voffB); PG8_STAGE_A(PG8_SA(1, 0), cA + kstep, 0, vgC); PG8_STAGE(PG8_SB(1, 1), cB + hstep + kstep, voffB);
    PG8_WAIT_V(6); PG8_BAR;
    for (;;) {
        if constexpr (Epi::PRE) E.unit_begin(cur, ui, wid, lane);
        const bool has2 = has_next && S.next(ui + 2, nn);
        const char* nA = GATHER ? (const char*)g.A : (has_next ? (const char*)g.A + (size_t)nxt.pm * tstep : cA); const char* nB = has_next ? (const char*)g.Bt + nxt.bo : cB;
        if constexpr (GATHER) {
#pragma unroll
            for (int h = 0; h < 2; ++h)
#pragma unroll
                for (int i = 0; i < 2; ++i) vgN[h][i] = has_next ? S.a_off_lds(nxt, (ui + 1) & 1, h, RA[i], CA[i]) : vgC[h][i];
            if (has2) S.stage_list(nn, ui & 1, wid, lane);
            asm volatile("" : "+v"(vgN[0][0]), "+v"(vgN[0][1]), "+v"(vgN[1][0]), "+v"(vgN[1][1]));
        }
        for (int hk = 0; hk < (Epi::MID ? 2 : 1); ++hk) {
        const int t0 = Epi::MID ? hk * (nt >> 1) : 0, t1 = Epi::MID ? (hk + 1) * (nt >> 1) : nt;
        for (int t = t0; t < t1; t += 2) {
            const bool last = (t == nt - 2);
            const char* a1 = cA + (size_t)(t + 1) * kstep;
            const char* a2 = last ? nA : cA + (size_t)(t + 2) * kstep; const char* b2 = last ? nB : cB + (size_t)(t + 2) * kstep;
            const char* a3 = a2 + kstep; const char* b3 = b2 + kstep;
            unsigned va2[2][2];
#pragma unroll
            for (int h = 0; h < 2; ++h)
#pragma unroll
                for (int i = 0; i < 2; ++i) va2[h][i] = last ? vgN[h][i] : vgC[h][i];
            PG8_LDB(B0, 0, 0); PG8_LDB(B1, 0, 1); PG8_SCHED; PG8_LDA(At, 0, 0); PG8_STAGE_A(PG8_SA(1, 1), a1, 1, vgC);
            PG8_WAIT_V(8); PG8_WAIT_L(0); PG8_BAR; PG8_MMA(0, 0, At, B0); PG8_MMA(0, 1, At, B1); PG8_BAR; PG8_SCHED;
            PG8_LDA(At, 0, 1); PG8_STAGE(PG8_SB(0, 0), b2, voffB); PG8_STAGE(PG8_SB(0, 1), b2 + hstep, voffB); PG8_STAGE_A(PG8_SA(0, 0), a2, 0, va2);
            PG8_WAIT_V(8); PG8_WAIT_L(0); PG8_BAR; PG8_MMA(1, 0, At, B0); PG8_MMA(1, 1, At, B1); PG8_BAR; PG8_SCHED;
            PG8_LDB(B0, 1, 0); PG8_LDB(B1, 1, 1); PG8_SCHED; PG8_LDA(At, 1, 0); PG8_STAGE_A(PG8_SA(0, 1), a2, 1, va2);
            PG8_WAIT_V(8); PG8_WAIT_L(0); PG8_BAR; PG8_MMA(0, 0, At, B0); PG8_MMA(0, 1, At, B1); PG8_BAR; PG8_SCHED;
            PG8_LDA(At, 1, 1); PG8_STAGE(PG8_SB(1, 0), b3, voffB); PG8_STAGE(PG8_SB(1, 1), b3 + hstep, voffB); PG8_STAGE_A(PG8_SA(1, 0), a3, 0, va2);
            PG8_WAIT_V(8); PG8_WAIT_L(0); PG8_BAR; PG8_MMA(1, 0, At, B0); PG8_MMA(1, 1, At, B1); PG8_BAR; PG8_SCHED;
        }
        if constexpr (Epi::MID) { if (hk == 0) { int l2 = lane; asm volatile("" : "+v"(l2)); E.mid(acc, ui, wr, l2 & 15); } }
        }
        if (PG8_ALIGN_EPI) { if (wr == 0) PG8_BAR; }
        { int l2 = lane; asm volatile("" : "+v"(l2)); E(acc, cur, ui, wr, wc, l2 & 15, l2 >> 4); }
        if (!has_next) break;
#pragma unroll
        for (int a = 0; a < 2; ++a)
#pragma unroll
            for (int b = 0; b < 2; ++b)
#pragma unroll
                for (int m = 0; m < 4; ++m)
#pragma unroll
                    for (int n = 0; n < 2; ++n) acc[a][b][m][n] = (f32x4){0.f, 0.f, 0.f, 0.f};
        cur = nxt; nxt = nn; has_next = has2; cA = nA; cB = nB; ++ui;
        if constexpr (GATHER) {
#pragma unroll
            for (int h = 0; h < 2; ++h)
#pragma unroll
                for (int i = 0; i < 2; ++i) vgC[h][i] = vgN[h][i];
        }
        if (PG8_ALIGN_EPI) { if (wr == 1) PG8_BAR; }
    }
    PG8_WAIT_V(0);
    if (!PG8_ALIGN_EPI) { if (wr == 0) PG8_BAR; }
    PG8_BAR;
#undef PG8_SA
#undef PG8_SB
#undef PG8_STAGE
#undef PG8_STAGE_A
#undef PG8_LDA
#undef PG8_LDB
#undef PG8_MMA
#undef PG8_WAIT_V
#undef PG8_WAIT_L
#undef PG8_BAR
#undef PG8_SCHED
}
}

#define XB_TMO      128
#define XB_XCNT(j)  (256  + 64 * (j))
#define XB_XSUB(j)  (1280 + 64 * (j))
#define XB_XGEN(j)  (2304 + 64 * (j))
#define XB_TOP      3328
#define XB_TOPGEN   3392
#define XCD_BAR_WORDS 3456
#define XB_SPIN_CAP (1u << 18)
static_assert(XCD_BAR_WORDS == XCD_BAR_WORDS_C, "barrier words");
__device__ __forceinline__ unsigned xb_ld(unsigned* p)              { return __hip_atomic_load(p, __ATOMIC_RELAXED, __HIP_MEMORY_SCOPE_AGENT); }
__device__ __forceinline__ unsigned xb_add(unsigned* p, unsigned v) { return __hip_atomic_fetch_add(p, v, __ATOMIC_RELAXED, __HIP_MEMORY_SCOPE_AGENT); }
__device__ __forceinline__ unsigned xb_xcc_id() { return (unsigned)__builtin_amdgcn_s_getreg((3 << 11) | 20) & 0xFu; }
#define XB_SPIN(cond, bar) do { unsigned _sp = 0; while (cond) { __builtin_amdgcn_s_sleep(1); \
    if ((++_sp & 255u) == 0u) { if (xb_ld(&(bar)[XB_TMO])) break; if (_sp > XB_SPIN_CAP) { atomicAdd(&(bar)[XB_TMO], 1u); break; } } } } while (0)
struct XcdBarrier { unsigned* bar; unsigned x; volatile LAS unsigned* st; };
__device__ __forceinline__ XcdBarrier xcd_barrier_post(unsigned* bar, volatile LAS unsigned* st) {
    XcdBarrier b; b.bar = bar; b.x = xb_xcc_id(); b.st = st;
    if (threadIdx.x == 0) (void)xb_add(&bar[XB_XCNT(b.x)], 1u);
    return b;
}
__device__ __forceinline__ void xcd_barrier_complete(unsigned* bar, unsigned x, unsigned& nloc, unsigned& nx) {
    const unsigned G = gridDim.x * gridDim.y * gridDim.z;
    unsigned sum, cnt, mine, sp = 0u;
    for (;;) {
        sum = 0u; cnt = 0u; mine = 0u;
#pragma unroll
        for (unsigned j = 0; j < 16; ++j) { const unsigned c = xb_ld(&bar[XB_XCNT(j)]); sum += c; cnt += (c > 0u) ? 1u : 0u; mine = (j == x) ? c : mine; }
        if (sum == G) break;
        __builtin_amdgcn_s_sleep(1);
        if ((++sp & 255u) == 0u) { if (xb_ld(&bar[XB_TMO])) break; if (sp > XB_SPIN_CAP) { atomicAdd(&bar[XB_TMO], 1u); break; } }
    }
    nloc = mine > 0u ? mine : 1u; nx = cnt > 0u ? cnt : 1u;
}
__device__ __forceinline__ void xcd_barrier(const XcdBarrier& b, int tid) {
    asm volatile("s_waitcnt vmcnt(0)" ::: "memory");
    __syncthreads();
    if (tid == 0) {
        __attribute__((address_space(1))) unsigned* barg = (__attribute__((address_space(1))) unsigned*)b.bar; unsigned bx_ = b.x; asm volatile("" : "+s"(barg), "+s"(bx_)); unsigned* bar = (unsigned*)barg;
        __builtin_amdgcn_s_waitcnt(0);
        unsigned nloc = b.st[0], nx = b.st[1]; const unsigned nb = b.st[2]; b.st[2] = nb + 1u;
        if (nloc == 0u) { xcd_barrier_complete(bar, bx_, nloc, nx); b.st[0] = nloc; b.st[1] = nx; }
        const unsigned old = xb_add(&bar[XB_XSUB(bx_)], 1u);
        const unsigned gen = old / nloc;
        if (old + 1u == (gen + 1u) * nloc) {
            __builtin_amdgcn_fence(__ATOMIC_RELEASE, "agent");
            asm volatile("s_waitcnt vmcnt(0)" ::: "memory");
            const unsigned og = xb_add(&bar[XB_TOP], 1u);
            const unsigned tg = og / nx;
            if (og + 1u == (tg + 1u) * nx) xb_add(&bar[XB_TOPGEN], 1u);
            else XB_SPIN(xb_ld(&bar[XB_TOPGEN]) == tg, bar);
            __builtin_amdgcn_fence(__ATOMIC_ACQUIRE, "agent");
            asm volatile("s_waitcnt vmcnt(0)" ::: "memory");
        } else {
            XB_SPIN(xb_ld(&bar[XB_TOPGEN]) == nb, bar);
            __builtin_amdgcn_fence(__ATOMIC_ACQUIRE, "agent");
            asm volatile("s_waitcnt vmcnt(0)" ::: "memory");
        }
    }
    __syncthreads();
}

struct Args { const float* in[33]; float* out; unsigned char* ws; int ph_lo, ph_hi, li, pad; };
typedef float f32x4 __attribute__((ext_vector_type(4)));
typedef unsigned u32x4 __attribute__((ext_vector_type(4)));
typedef unsigned u32x2 __attribute__((ext_vector_type(2)));
typedef short bf16x8 __attribute__((ext_vector_type(8)));
#define LDS_WAIT() asm volatile("s_waitcnt lgkmcnt(0)" ::: "memory")
template <class TT> __device__ __forceinline__ TT ldg(const void* ubase, unsigned off) { return *(const TT*)((const char*)ubase + off); }
template <class TT> __device__ __forceinline__ void stg(void* ubase, unsigned off, TT v) { *(TT*)((char*)ubase + off) = v; }
#define CBAR() asm volatile("" ::: "memory")

constexpr int TRJ0 = 16 * 48, TRJ1 = TRJ0 + 8 * 32, TRJ2 = TRJ1 + 16 * 32, TRJ3 = TRJ2 + NE * 256, TRJ4 = TRJ3 + NE * 256, TRJ = TRJ4 + NE * 256;
#define TR_DECODE(L_, it_, W_, WT_, K_, N_, IL_, OFF_, K0_, N0_) do { const int it__ = (it_); \
    if (it__ < TRJ0) { const int q = it__; W_ = a.in[1] + (size_t)(L_) * D * NPROJ; WT_ = WinT + (size_t)(L_) * NPROJ * D; K_ = D; N_ = NPROJ; IL_ = 0; OFF_ = 0; K0_ = (q / 48) * 64; N0_ = (q % 48) * 32; } \
    else if (it__ < TRJ1) { const int q = it__ - TRJ0; W_ = a.in[17] + (size_t)(L_) * 512 * 1024; WT_ = WgluT + (size_t)(L_) * 1024 * 512; K_ = 512; N_ = 1024; IL_ = 1; OFF_ = 0; K0_ = (q / 32) * 64; N0_ = (q % 32) * 32; } \
    else if (it__ < TRJ2) { const int q = it__ - TRJ1; W_ = a.in[21] + (size_t)(L_) * 1024 * 1024; WT_ = WoutT + (size_t)(L_) * 1024 * 1024; K_ = 1024; N_ = 1024; IL_ = 0; OFF_ = 0; K0_ = (q / 32) * 64; N0_ = (q % 32) * 32; } \
    else if (it__ < TRJ3) { const int r = it__ - TRJ2, bt = (L_) * NE + (r >> 8), q = r & 255; W_ = a.in[28] + (size_t)bt * 1024 * 512; WT_ = WguT + (size_t)bt * 1024 * 1024; K_ = 1024; N_ = 512; IL_ = 1; OFF_ = 0; K0_ = (q / 16) * 64; N0_ = (q % 16) * 32; } \
    else if (it__ < TRJ4) { const int r = it__ - TRJ3, bt = (L_) * NE + (r >> 8), q = r & 255; W_ = a.in[29] + (size_t)bt * 1024 * 512; WT_ = WguT + (size_t)bt * 1024 * 1024; K_ = 1024; N_ = 512; IL_ = 1; OFF_ = 4; K0_ = (q / 16) * 64; N0_ = (q % 16) * 32; } \
    else { const int r = it__ - TRJ4, bt = (L_) * NE + (r >> 8), q = r & 255; W_ = a.in[30] + (size_t)bt * 512 * 1024; WT_ = WdT + (size_t)bt * 1024 * 512; K_ = 512; N_ = 1024; IL_ = 2; OFF_ = 0; K0_ = (q / 32) * 64; N0_ = (q % 32) * 32; } } while (0)
#define TR_DMA(scr_, W_, N_, K0_, N0_) do { _Pragma("unroll") for (int i_ = 0; i_ < 8; ++i_) \
    __builtin_amdgcn_global_load_lds((const unsigned*)((W_) + (size_t)((K0_) + 8 * i_ + (lane >> 3)) * (N_) + (N0_) + 4 * ((lane & 7) ^ i_)), (LAS unsigned*)((LAS unsigned char*)(scr_) + i_ * 1024), 16, 0, 0); } while (0)
#define TR_OUT(scr_, WT_, K_, IL_, OFF_, K0_, N0_) do { const int c8_ = lane & 7; \
    _Pragma("unroll") for (int j_ = 0; j_ < 4; ++j_) { const int nl_ = (lane >> 3) + 8 * j_, n_ = (N0_) + nl_; const LAS float* s_ = (scr_) + (8 * c8_) * 32 + (nl_ ^ (4 * c8_)); \
        u32x4 o_; o_.x = pk2(s_[0], s_[32]); o_.y = pk2(s_[64], s_[96]); o_.z = pk2(s_[128], s_[160]); o_.w = pk2(s_[192], s_[224]); \
        const int oc_ = n_ & 511; const int r_ = ((IL_) == 1) ? (256 * (oc_ >> 7) + 128 * ((oc_ >> 2) & 1) + 32 * ((oc_ >> 5) & 3) + 8 * ((oc_ >> 3) & 3) + (oc_ & 3) + 4 * (n_ >> 9) + (OFF_)) : ((IL_) == 2) ? ((n_ & ~255) + 128 * ((n_ >> 5) & 1) + 32 * ((n_ >> 6) & 3) + (n_ & 31)) : n_; \
        *(u32x4*)((WT_) + (size_t)r_ * (K_) + (K0_) + 8 * c8_) = o_; } \
    CBAR(); } while (0)
#define TR_STORE(v_, scr_, WT_, K_, IL_, OFF_, K0_, N0_) do { \
    _Pragma("unroll") for (int i_ = 0; i_ < 8; ++i_) { const int k_ = 8 * i_ + (lane >> 3), c_ = 4 * (lane & 7); *(LAS f32x4*)((scr_) + k_ * 32 + (c_ ^ (4 * ((k_ >> 3) & 7)))) = v_[i_]; } \
    { const int c8_ = lane & 7; \
    _Pragma("unroll") for (int j_ = 0; j_ < 4; ++j_) { const int nl_ = (lane >> 3) + 8 * j_, n_ = (N0_) + nl_; const LAS float* s_ = (scr_) + (8 * c8_) * 32 + (nl_ ^ (4 * c8_)); \
        u32x4 o_; o_.x = pk2(s_[0], s_[32]); o_.y = pk2(s_[64], s_[96]); o_.z = pk2(s_[128], s_[160]); o_.w = pk2(s_[192], s_[224]); \
        const int oc_ = n_ & 511; const int r_ = ((IL_) == 1) ? (256 * (oc_ >> 7) + 128 * ((oc_ >> 2) & 1) + 32 * ((oc_ >> 5) & 3) + 8 * ((oc_ >> 3) & 3) + (oc_ & 3) + 4 * (n_ >> 9) + (OFF_)) : ((IL_) == 2) ? ((n_ & ~255) + 128 * ((n_ >> 5) & 1) + 32 * ((n_ >> 6) & 3) + (n_ & 31)) : n_; \
        *(u32x4*)((WT_) + (size_t)r_ * (K_) + (K0_) + 8 * c8_) = o_; } } \
    CBAR(); } while (0)
#define TR_LOAD(v_, W_, N_, K0_, N0_) do { const unsigned vo_ = (unsigned)((lane >> 3) * (N_) + 4 * (lane & 7)) * 4u; _Pragma("unroll") for (int i_ = 0; i_ < 8; ++i_) v_[i_] = ldg<f32x4>((W_) + (size_t)((K0_) + 8 * i_) * (N_) + (N0_), vo_); } while (0)
__global__ void __launch_bounds__(NTHREADS, 2) mk_fwd(Args a) {
    extern __shared__ __attribute__((aligned(16))) unsigned char lds_raw[];
    LAS unsigned char* lds = (LAS unsigned char*)lds_raw;
    const int tid = threadIdx.x, wave0 = __builtin_amdgcn_readfirstlane(tid >> 6);
    const int G0 = gridDim.x, bx0 = blockIdx.x;
    unsigned char* ws = a.ws; unsigned* ctl = (unsigned*)(ws + WS_CTL); float* xf = a.out;
    volatile LAS unsigned* lc_bar = (volatile LAS unsigned*)(lds + LDS_CTL + LC_BAR);
    for (int u = tid; u < LDS_RING / 4; u += NTHREADS) ((LAS unsigned*)(lds + LDS_CTL))[u] = 0u;
    __syncthreads();
    XcdBarrier bar = xcd_barrier_post(ctl + CW_BAR + a.li * XCD_BAR_WORDS, lc_bar);

    if (a.ph_lo == 0) {
        const int ph = 0;
        int G_ = G0, bx_ = bx0, wave_ = wave0; asm volatile("" : "+s"(G_), "+s"(bx_), "+s"(wave_));
        const int G = G_, bx = bx_, wave = wave_, vcu = (G % 8 == 0) ? (bx % 8) * (G / 8) + bx / 8 : bx, gw = vcu * NWAVES + wave, NGW = G * NWAVES;
        int tid; asm volatile("v_mbcnt_lo_u32_b32 %0, -1, 0\n\tv_mbcnt_hi_u32_b32 %0, -1, %0\n\tv_add_u32 %0, %1, %0" : "=v"(tid) : "s"(wave * 64));
        const int lane = tid & 63;
        const char __attribute__((address_space(4)))* kp_ = (const char __attribute__((address_space(4)))*)__builtin_amdgcn_kernarg_segment_ptr(); asm volatile("" : "+s"(kp_));
        const float* const __attribute__((address_space(4)))* in_ = (const float* const __attribute__((address_space(4)))*)kp_;
        LAS unsigned char* ldp = lds; asm volatile("" : "+s"(ldp));
        LAS unsigned char* ring = ldp + LDS_RING;
        LAS int* lc_tb = (LAS int*)(ldp + LDS_CTL + LC_TB); LAS unsigned* lc_cn = (LAS unsigned*)(ldp + LDS_CTL + LC_CN);
        LAS unsigned* lc_lcnt = (LAS unsigned*)(ldp + LDS_CTL + LC_LCNT); LAS unsigned* lc_gb = (LAS unsigned*)(ldp + LDS_CTL + LC_GB);
        LAS int* lc_ent = (LAS int*)(ldp + LDS_CTL + LC_ENT); LAS unsigned* lc_rank = (LAS unsigned*)(ldp + LDS_CTL + LC_RANK); LAS float* lc_gv = (LAS float*)(ldp + LDS_CTL + LC_GV);
        __attribute__((address_space(1))) unsigned char* wsg = (__attribute__((address_space(1))) unsigned char*)ws; asm volatile("" : "+s"(wsg)); unsigned char* wsp = (unsigned char*)wsg;
        bf16 *WinT = (bf16*)(wsp + WS_WIN), *WgluT = (bf16*)(wsp + WS_WGLU), *WoutT = (bf16*)(wsp + WS_WOUT), *WguT = (bf16*)(wsp + WS_WGU), *WdT = (bf16*)(wsp + WS_WD), *WrT = (bf16*)(wsp + WS_WRT);
        float* a16t = (float*)(wsp + WS_A16); float* rcst = (float*)(wsp + WS_RC);
        bf16 *B16 = (bf16*)(wsp + WS_B16), *WS5 = (bf16*)(wsp + WS_WS5), *WgT = (bf16*)(wsp + WS_WGT); float* gbias = (float*)(wsp + WS_GB);
        bf16 *xb = (bf16*)(wsp + WS_XB), *proj = (bf16*)(wsp + WS_PROJ), *ys = (bf16*)(wsp + WS_YS), *yrec = (bf16*)(wsp + WS_YREC), *ug = (bf16*)(wsp + WS_UG), *ycat = (bf16*)(wsp + WS_YCAT);
        bf16 *Hb = (bf16*)(wsp + WS_H), *Yb = (bf16*)(wsp + WS_Y);
        float *ss1p = (float*)(wsp + WS_YREC), *ss2p = (float*)(wsp + WS_UG);
        float* gate = (float*)(wsp + WS_GATE); int* list = (int*)(wsp + WS_LIST);
        {
            LAS float* scr = (LAS float*)(ring + wave * 16384);
            const int gwl = vcu * NWAVES + __builtin_amdgcn_readfirstlane(tid >> 6);
            const int TRN = (NGW == 2048) ? TRJ0 : DEPTH * TRJ;
            if (gwl < TRN) {
                const float* cW; bf16* cWT; int cK, cN, cIL, cOFF, cK0, cN0; f32x4 v[8];
                TR_DECODE(gwl / TRJ, gwl % TRJ, cW, cWT, cK, cN, cIL, cOFF, cK0, cN0); TR_LOAD(v, cW, cN, cK0, cN0);
                for (int it = gwl;;) {
                    const float* nW; bf16* nWT; int nK, nN, nIL, nOFF, nK0, nN0; f32x4 vn[8];
                    const int itn = it + NGW; const bool more = itn < TRN; const int itd = more ? itn : it;
                    TR_DECODE(itd / TRJ, itd % TRJ, nW, nWT, nK, nN, nIL, nOFF, nK0, nN0); TR_LOAD(vn, nW, nN, nK0, nN0);
                    { const int cj = it % TRJ; if (!(cj >= TRJ1 && cj < TRJ2)) TR_STORE(v, scr, cWT, cK, cIL, cOFF, cK0, cN0); }
                    if (!more) break;
#pragma unroll
                    for (int i = 0; i < 8; ++i) v[i] = vn[i];
                    cW = nW; cWT = nWT; cK = nK; cN = nN; cIL = nIL; cOFF = nOFF; cK0 = nK0; cN0 = nN0; it = itn;
                }
            }
            { const int c8 = lane & 7;
              for (int j = gwl; j < DEPTH * 512; j += NGW) {
                const int wl = j >> 9, K0 = ((j & 511) >> 5) * 64, N0 = (j & 31) * 32;
                const float* W = in_[21] + (size_t)wl * 1024 * 1024; bf16* WT = WoutT + (size_t)wl * 1024 * 1024;
                f32x4 v[8]; TR_LOAD(v, W, 1024, K0, N0);
                const float* gp = (K0 < 512) ? in_[19] + wl * 512 + K0 : in_[20] + wl * 512 + (K0 - 512);
                const f32x4 g0 = *(const f32x4*)(gp + 8 * c8), g1 = *(const f32x4*)(gp + 8 * c8 + 4);
#pragma unroll
                for (int i_ = 0; i_ < 8; ++i_) { const int k_ = 8 * i_ + (lane >> 3), c_ = 4 * (lane & 7); *(LAS f32x4*)(scr + k_ * 32 + (c_ ^ (4 * ((k_ >> 3) & 7)))) = v[i_]; }
#pragma unroll
                for (int j_ = 0; j_ < 4; ++j_) { const int nl_ = (lane >> 3) + 8 * j_, n_ = N0 + nl_; const LAS float* s_ = scr + (8 * c8) * 32 + (nl_ ^ (4 * c8));
                    u32x4 o_; o_.x = pk2(s_[0] * g0[0], s_[32] * g0[1]); o_.y = pk2(s_[64] * g0[2], s_[96] * g0[3]); o_.z = pk2(s_[128] * g1[0], s_[160] * g1[1]); o_.w = pk2(s_[192] * g1[2], s_[224] * g1[3]);
                    *(u32x4*)(WT + (size_t)n_ * 1024 + K0 + 8 * c8) = o_; }
                CBAR(); } }
            const int gt = vcu * NTHREADS + tid, NGT = G * NTHREADS;
            for (int idx = gt; idx < DEPTH * 48 * D; idx += NGT) { const int l = idx / (48 * D), n = (idx / D) % 48, k = idx % D;
                const float v = n < 32 ? in_[26][((size_t)l * D + k) * NE + n] : (n < 36 ? in_[24][((size_t)l * D + k) * NEG + (n - 32)] : 0.f);
                WrT[(size_t)l * 48 * D + ((((n >> 4) * 32 + (k >> 5)) * 64) + (n & 15) + 16 * ((k >> 3) & 3)) * 8 + (k & 7)] = f2bf(v * in_[22][l * D + k]); }
            for (int idx = gw; idx < DEPTH * 48; idx += NGW) { const int l = idx / 48, n = idx % 48; float c1 = 0.f, c0 = 0.f;
                float wv[16], gv[16], bv[16];
#pragma unroll
                for (int i = 0; i < 16; ++i) { const int k = lane + 64 * i; wv[i] = n < 32 ? in_[26][((size_t)l * D + k) * NE + n] : (n < 36 ? in_[24][((size_t)l * D + k) * NEG + (n - 32)] : 0.f);
                    gv[i] = in_[22][l * D + k]; bv[i] = in_[23][l * D + k]; }
#pragma unroll
                for (int i = 0; i < 16; ++i) { c1 += bf2f(f2bf(wv[i] * gv[i])); c0 += wv[i] * bv[i]; }
                c1 = wave_sum(c1, lane); c0 = wave_sum(c0, lane);
                c0 += n < 32 ? in_[27][l * NE + n] : (n < 36 ? in_[25][l * NEG + (n - 32)] : 0.f);
                if (lane == 0) { rcst[(l * 2 + 0) * 48 + n] = c1; rcst[(l * 2 + 1) * 48 + n] = c0; } }
            for (int idx0 = gt; idx0 < DEPTH * NGRP * 2 * GC * 256; idx0 += NGT * 8) {
                float wv[8], mv[8];
#pragma unroll
                for (int j = 0; j < 8; ++j) { const int idx = idx0 + j * NGT;
                    if (idx < DEPTH * NGRP * 2 * GC * 256) { const int lg = idx >> 13, gsel = (idx >> 12) & 1, c = (idx >> 8) & 15, kk = idx & 255, tap = kk >> 6, i = kk & 63, l = lg / NGRP, g = lg % NGRP, hh = g >> 2, jh = GC * (g & 3) + c;
                        wv[j] = in_[2][((size_t)l * 4 + tap) * DREC + HD * hh + i]; mv[j] = in_[gsel ? 6 : 4][(((size_t)l * NH + hh) * HD + i) * HD + jh]; } else { wv[j] = 0.f; mv[j] = 0.f; } }
#pragma unroll
                for (int j = 0; j < 8; ++j) { const int idx = idx0 + j * NGT; if (idx < DEPTH * NGRP * 2 * GC * 256) { const int c = (idx >> 8) & 15, kk = idx & 255;
                        WgT[(idx & ~4095) + (((kk >> 5) * 64) + c + 16 * ((kk >> 3) & 3)) * 8 + (kk & 7)] = f2bf(wv[j] * mv[j]); } } }
            for (int idx = gw; idx < DEPTH * NGRP * 2 * GC; idx += NGW) {
                const int lg = idx >> 5, gsel = (idx >> 4) & 1, c = idx & 15, l = lg / NGRP, g = lg % NGRP, hh = g >> 2, jh = GC * (g & 3) + c;
                float s = in_[3][l * DREC + HD * hh + lane] * in_[gsel ? 6 : 4][(((size_t)l * NH + hh) * HD + lane) * HD + jh];
                s = wave_sum(s, lane);
                if (lane == 0) gbias[idx] = s + in_[gsel ? 7 : 5][l * DREC + HD * hh + jh]; }
            {
                LAS float* pwr = (LAS float*)ring; LAS float* pwi = pwr + 64 * 17; LAS float* bbr = pwi + 64 * 17; LAS float* bbi = bbr + 1024;
                LAS float* cmr = bbi + 1024; LAS float* cmi = cmr + 1024; LAS float* ktl = cmi + 1024;
                for (int lg = vcu; lg < DEPTH * NGRP; lg += G) {
                    __syncthreads();
                    if (tid < NST) { const int sn = lg * NST + tid;
                        const float lre = fminf(in_[9][sn], -1e-4f), lim = in_[10][sn], dt = expf(in_[11][lg]);
                        const float mag = expf(lre * dt), ar = mag * cosf(lim * dt), ai = mag * sinf(lim * dt);
                        const float den = lre * lre + lim * lim, pr0 = ar - 1.f, pi0 = ai;
                        const float cr = (pr0 * lre + pi0 * lim) / den, ci = (pi0 * lre - pr0 * lim) / den;
                        float pr = 1.f, pi = 0.f;
                        for (int tau = 0; tau <= 16; ++tau) { pwr[tid * 17 + tau] = pr; pwi[tid * 17 + tau] = pi; const float nr = pr * ar - pi * ai, ni = pr * ai + pi * ar; pr = nr; pi = ni; }
                        a16t[sn * 2] = pwr[tid * 17 + 16]; a16t[sn * 2 + 1] = pwi[tid * 17 + 16];
                        f32x4 brv[4], biv[4];
#pragma unroll
                        for (int c4 = 0; c4 < 4; ++c4) { brv[c4] = *(const f32x4*)(in_[12] + (size_t)sn * GC + 4 * c4); biv[c4] = *(const f32x4*)(in_[13] + (size_t)sn * GC + 4 * c4); }
#pragma unroll
                        for (int c = 0; c < GC; ++c) { const float br = brv[c >> 2][c & 3], bi = biv[c >> 2][c & 3];
                            bbr[tid * GC + c] = cr * br - ci * bi; bbi[tid * GC + c] = cr * bi + ci * br; } }
                    for (int i = tid; i < GC * NST; i += NTHREADS) { cmr[i] = in_[14][(size_t)lg * GC * NST + i]; cmi[i] = in_[15][(size_t)lg * GC * NST + i]; }
                    __syncthreads();
                    for (int i = tid; i < 4096; i += NTHREADS) { const int tau = i >> 8, co = (i >> 4) & 15, ci = i & 15; float s = 0.f;
                        for (int n = 0; n < NST; ++n) { const float c_r = cmr[co * NST + n], c_i = cmi[co * NST + n], p_r = pwr[n * 17 + tau], p_i = pwi[n * 17 + tau];
                            const float mr = c_r * p_r - c_i * p_i, mi = c_r * p_i + c_i * p_r; s += mr * bbr[n * GC + ci] - mi * bbi[n * GC + ci]; }
                        if (tau == 0 && co == ci) s += in_[16][lg * GC + co];
                        ktl[i] = s; }
                    __syncthreads();
                    for (int i = tid; i < 256 * 384; i += NTHREADS) { const int e_ = i & 7, ln = (i >> 3) & 63, fk = i >> 9, nt_ = fk / 12, ks_ = fk - nt_ * 12;
                        const int n = 16 * nt_ + (ln & 15), kk = (ks_ < 4 ? 256 + 32 * ks_ : 32 * (ks_ - 4)) + 8 * (ln >> 4) + e_, tp = n >> 4, co = n & 15; float v;
                        if (kk < 256) { const int sp = kk >> 4, ci = kk & 15; v = (sp <= tp) ? ktl[((tp - sp) * 16 + co) * 16 + ci] : 0.f; }
                        else { const int nn = (kk - 256) >> 1; const float c_r = cmr[co * NST + nn], c_i = cmi[co * NST + nn], p_r = pwr[nn * 17 + tp + 1], p_i = pwi[nn * 17 + tp + 1];
                            const float mr = c_r * p_r - c_i * p_i, mi = c_r * p_i + c_i * p_r; v = (kk & 1) ? -mi : mr; }
                        WS5[(size_t)lg * 256 * 384 + i] = f2bf(v); }
                    for (int i = tid; i < 128 * 256; i += NTHREADS) { const int e_ = i & 7, ln = (i >> 3) & 63, fk = i >> 9, nt_ = fk >> 3, ks_ = fk & 7;
                        const int np = 16 * nt_ + (ln & 15), kk = 32 * ks_ + 8 * (ln >> 4) + e_, tp = kk >> 4, c = kk & 15, n = np & 63;
                        const float p_r = pwr[n * 17 + 15 - tp], p_i = pwi[n * 17 + 15 - tp], br = bbr[n * GC + c], bi = bbi[n * GC + c];
                        B16[(size_t)lg * 128 * 256 + i] = f2bf(np < 64 ? (p_r * br - p_i * bi) : (p_r * bi + p_i * br)); }
                }
                __syncthreads();
            }
            { const f32x4* xs = (const f32x4*)in_[0]; u32x2* xd = (u32x2*)xb; const size_t n4 = (size_t)T * D / 4;
              const bool split = (G == 256); const int xg = split ? (vcu - 128) * NTHREADS + tid : gt, XN = split ? 128 * NTHREADS : NGT;
              if (!split || vcu >= 128)
              for (size_t i = (size_t)xg; i < n4; i += (size_t)XN * 8) { f32x4 v[8];
#pragma unroll
                for (int j = 0; j < 8; ++j) { const size_t ii = i + (size_t)j * XN; v[j] = ii < n4 ? xs[ii] : (f32x4){0.f, 0.f, 0.f, 0.f}; }
#pragma unroll
                for (int j = 0; j < 8; ++j) { const size_t ii = i + (size_t)j * XN; if (ii < n4) { u32x2 w; w.x = pk2(v[j][0], v[j][1]); w.y = pk2(v[j][2], v[j][3]); xd[ii] = w; } } } }
        }
        if (1 < a.ph_hi) xcd_barrier(bar, tid);
    }
    for (int ph = (a.ph_lo < 1 ? 1 : a.ph_lo); ph < a.ph_hi; ++ph) {
      const int kind = (ph - 1) % 10; const int reps = ((a.pad >> kind) & 1) ? 2 : 1;
      for (int rep = 0; rep < reps; ++rep) {
        int G_ = G0, bx_ = bx0, wave_ = wave0; asm volatile("" : "+s"(G_), "+s"(bx_), "+s"(wave_));
        const int G = G_, bx = bx_, wave = wave_, vcu = (G % 8 == 0) ? (bx % 8) * (G / 8) + bx / 8 : bx, gw = vcu * NWAVES + wave, NGW = G * NWAVES;
        int tid; asm volatile("v_mbcnt_lo_u32_b32 %0, -1, 0\n\tv_mbcnt_hi_u32_b32 %0, -1, %0\n\tv_add_u32 %0, %1, %0" : "=v"(tid) : "s"(wave * 64));
        const int lane = tid & 63;
        const char __attribute__((address_space(4)))* kp_ = (const char __attribute__((address_space(4)))*)__builtin_amdgcn_kernarg_segment_ptr(); asm volatile("" : "+s"(kp_));
        const float* const __attribute__((address_space(4)))* in_ = (const float* const __attribute__((address_space(4)))*)kp_;
        LAS unsigned char* ldp = lds; asm volatile("" : "+s"(ldp));
        LAS unsigned char* ring = ldp + LDS_RING;
        LAS int* lc_tb = (LAS int*)(ldp + LDS_CTL + LC_TB); LAS unsigned* lc_cn = (LAS unsigned*)(ldp + LDS_CTL + LC_CN);
        LAS unsigned* lc_lcnt = (LAS unsigned*)(ldp + LDS_CTL + LC_LCNT); LAS unsigned* lc_gb = (LAS unsigned*)(ldp + LDS_CTL + LC_GB);
        LAS int* lc_ent = (LAS int*)(ldp + LDS_CTL + LC_ENT); LAS unsigned* lc_rank = (LAS unsigned*)(ldp + LDS_CTL + LC_RANK); LAS float* lc_gv = (LAS float*)(ldp + LDS_CTL + LC_GV);
        __attribute__((address_space(1))) unsigned char* wsg = (__attribute__((address_space(1))) unsigned char*)ws; asm volatile("" : "+s"(wsg)); unsigned char* wsp = (unsigned char*)wsg;
        bf16 *WinT = (bf16*)(wsp + WS_WIN), *WgluT = (bf16*)(wsp + WS_WGLU), *WoutT = (bf16*)(wsp + WS_WOUT), *WguT = (bf16*)(wsp + WS_WGU), *WdT = (bf16*)(wsp + WS_WD), *WrT = (bf16*)(wsp + WS_WRT);
        float* a16t = (float*)(wsp + WS_A16); float* rcst = (float*)(wsp + WS_RC);
        bf16 *B16 = (bf16*)(wsp + WS_B16), *WS5 = (bf16*)(wsp + WS_WS5), *WgT = (bf16*)(wsp + WS_WGT); float* gbias = (float*)(wsp + WS_GB);
        bf16 *xb = (bf16*)(wsp + WS_XB), *proj = (bf16*)(wsp + WS_PROJ), *ys = (bf16*)(wsp + WS_YS), *yrec = (bf16*)(wsp + WS_YREC), *ug = (bf16*)(wsp + WS_UG), *ycat = (bf16*)(wsp + WS_YCAT);
        bf16 *Hb = (bf16*)(wsp + WS_H), *Yb = (bf16*)(wsp + WS_Y);
        float *ss1p = (float*)(wsp + WS_YREC), *ss2p = (float*)(wsp + WS_UG);
        float* gate = (float*)(wsp + WS_GATE); int* list = (int*)(wsp + WS_LIST);
        {
            const int l = (ph - 1) / 10, k = (ph - 1) % 10;
            if (k == 0) {
                pg8::Gemm g{xb, WinT + (size_t)l * NPROJ * D, T, NPROJ, D}; pg8::StaticOrder S; S.init(T, NPROJ, D, G, bx);
                pg8::EpiProj E{proj};
                pg8::gemm_phase<pg8::EpiProj, pg8::StaticOrder, false>(ring, g, S, E, tid);
            } else if (k == 1) {
                const int r = lane & 15, q = lane >> 4;
                for (int item = vcu; item < BATCH * NGRP; item += G) {
                    const int b = item / NGRP, g = item % NGRP, lg = l * NGRP + g;
#pragma unroll
                    for (int pz = 0; pz < 2; ++pz) __builtin_amdgcn_global_load_lds((const unsigned*)((const char*)(WgT + (size_t)lg * 2 * GC * 256) + (wave + 8 * pz) * 1024 + lane * 16), (LAS unsigned*)(ring + 116736 + (wave + 8 * pz) * 1024), 16, 0, 0);
                    const bf16* pu = proj + (size_t)2 * T * 512 + (size_t)(b * NGRP + g) * SEQ * GC;
                    {
                        const bf16* Wl = WS5 + (size_t)lg * 256 * 384; const bf16* Bl = B16 + (size_t)lg * 128 * 256;
                        LAS float* wsl = (LAS float*)ring;
                        LAS unsigned char* CB = ring + 4096 + wave * 8704;
                        const unsigned voU = (unsigned)(r * 256 + 8 * q) * 2u, voF = (unsigned)lane * 16u;
                        bf16x8 uf[2][8];
#pragma unroll
                        for (int mt = 0; mt < 2; ++mt)
#pragma unroll
                            for (int ks = 0; ks < 8; ++ks) uf[mt][ks] = ldg<bf16x8>(pu + (32 * wave + 16 * mt) * 256 + 32 * ks, voU);
                        f32x4 eS[2][8];
#pragma unroll
                        for (int mt = 0; mt < 2; ++mt)
#pragma unroll
                            for (int nt = 0; nt < 8; ++nt) eS[mt][nt] = (f32x4){0.f, 0.f, 0.f, 0.f};
                        LAS unsigned char* BI = ring + 4096;
                        LAS unsigned char* WB = ring + 4096 + 69632;
#pragma unroll
                        for (int i = 0; i < 8; ++i) __builtin_amdgcn_global_load_lds((const unsigned*)((const char*)(Bl + (8 * wave + i) * 512) + voF), (LAS unsigned*)(BI + (8 * wave + i) * 1024), 16, 0, 0);
                        if (wave < 5) __builtin_amdgcn_global_load_lds((const unsigned*)((const char*)(Wl + wave * 512) + voF), (LAS unsigned*)(WB + wave * 1024), 16, 0, 0);
                        __syncthreads();
#pragma unroll
                        for (int nt = 0; nt < 8; ++nt)
#pragma unroll
                            for (int ks = 0; ks < 8; ks += 4) { bf16x8 bv[4];
#pragma unroll
                                for (int i = 0; i < 4; ++i) bv[i] = *(const LAS bf16x8*)(BI + (nt * 8 + ks + i) * 1024 + voF);
#pragma unroll
                                for (int i = 0; i < 4; ++i) { eS[0][nt] = __builtin_amdgcn_mfma_f32_16x16x32_bf16(uf[0][ks + i], bv[i], eS[0][nt], 0, 0, 0); eS[1][nt] = __builtin_amdgcn_mfma_f32_16x16x32_bf16(uf[1][ks + i], bv[i], eS[1][nt], 0, 0, 0); } }
                        float exr[2][4], exi[2][4], t0r[4], t0i[4];
                        f32x2_t a16v[4];
#pragma unroll
                        for (int s = 0; s < 4; ++s) a16v[s] = *(const f32x2_t*)(a16t + (size_t)(lg * NST + 16 * s + r) * 2);
#pragma unroll
                        for (int s = 0; s < 4; ++s) {
                            const float p1r = a16v[s][0], p1i = a16v[s][1];
                            const float p2r = p1r * p1r - p1i * p1i, p2i = (p1r + p1r) * p1i, p4r = p2r * p2r - p2i * p2i, p4i = (p2r + p2r) * p2i, p8r = p4r * p4r - p4i * p4i, p8i = (p4r + p4r) * p4i, p16r = p8r * p8r - p8i * p8i, p16i = (p8r + p8r) * p8i;
                            float wtr = 0.f, wti = 0.f;
#pragma unroll
                            for (int mt = 0; mt < 2; ++mt) {
                                float sr = eS[mt][s][0], si = eS[mt][s + 4][0];
#pragma unroll
                                for (int jj = 1; jj < 4; ++jj) { const float nr = p1r * sr - p1i * si + eS[mt][s][jj], ni = p1r * si + p1i * sr + eS[mt][s + 4][jj]; sr = nr; si = ni; eS[mt][s][jj] = sr; eS[mt][s + 4][jj] = si; }
                                float ir = sr, ii = si;
                                { const float nr = lane_get(ir, lane - 16), ni = lane_get(ii, lane - 16); if (q >= 1) { ir += p4r * nr - p4i * ni; ii += p4r * ni + p4i * nr; } }
                                { const float nr = lane_get(ir, lane - 32), ni = lane_get(ii, lane - 32); if (q >= 2) { ir += p8r * nr - p8i * ni; ii += p8r * ni + p8i * nr; } }
                                float er = lane_get(ir, lane - 16), ei = lane_get(ii, lane - 16); if (q == 0) { er = 0.f; ei = 0.f; }
                                exr[mt][s] = er; exi[mt][s] = ei;
                                const float ttr = lane_get(ir, 48 + r), tti = lane_get(ii, 48 + r);
                                if (mt == 0) { t0r[s] = ttr; t0i[s] = tti; wtr = ttr; wti = tti; } else { const float nr = p16r * wtr - p16i * wti + ttr, ni = p16r * wti + p16i * wtr + tti; wtr = nr; wti = ni; }
                            }
                            if (q == 0) { wsl[(wave * NST + 16 * s + r) * 2] = wtr; wsl[(wave * NST + 16 * s + r) * 2 + 1] = wti; }
                        }
                        __syncthreads();
#pragma unroll
                        for (int s = 0; s < 4; ++s) {
                            const float p1r = a16v[s][0], p1i = a16v[s][1];
                            const float p2r = p1r * p1r - p1i * p1i, p2i = (p1r + p1r) * p1i, p3r = p2r * p1r - p2i * p1i, p3i = p2r * p1i + p2i * p1r, p4r = p2r * p2r - p2i * p2i, p4i = (p2r + p2r) * p2i;
                            const float p8r = p4r * p4r - p4i * p4i, p8i = (p4r + p4r) * p4i, p12r = p8r * p4r - p8i * p4i, p12i = p8r * p4i + p8i * p4r, p16r = p8r * p8r - p8i * p8i, p16i = (p8r + p8r) * p8i, p32r = p16r * p16r - p16i * p16i, p32i = (p16r + p16r) * p16i;
                            float cr = 0.f, ci = 0.f;
                            for (int w2 = 0; w2 < wave; ++w2) { const float tr = wsl[(w2 * NST + 16 * s + r) * 2], ti = wsl[(w2 * NST + 16 * s + r) * 2 + 1]; const float nr = p32r * cr - p32i * ci + tr, ni = p32r * ci + p32i * cr + ti; cr = nr; ci = ni; }
                            const float pqr = (q == 0) ? 1.f : (q == 1) ? p4r : (q == 2) ? p8r : p12r, pqi = (q == 0) ? 0.f : (q == 1) ? p4i : (q == 2) ? p8i : p12i;
#pragma unroll
                            for (int mt = 0; mt < 2; ++mt) {
                                if (mt == 1) { const float nr = p16r * cr - p16i * ci + t0r[s], ni = p16r * ci + p16i * cr + t0i[s]; cr = nr; ci = ni; }
                                const float rsr = exr[mt][s] + pqr * cr - pqi * ci, rsi = exi[mt][s] + pqr * ci + pqi * cr;
                                const float c1r = p1r * rsr - p1i * rsi + eS[mt][s][0], c1i = p1r * rsi + p1i * rsr + eS[mt][s + 4][0];
                                const float c2r = p2r * rsr - p2i * rsi + eS[mt][s][1], c2i = p2r * rsi + p2i * rsr + eS[mt][s + 4][1];
                                const float c3r = p3r * rsr - p3i * rsi + eS[mt][s][2], c3i = p3r * rsi + p3i * rsr + eS[mt][s + 4][2];
                                LAS unsigned char* cp = CB + (16 * mt + 4 * q) * 272 + 64 * s + 4 * r;
                                *(LAS unsigned*)(cp) = pk2(rsr, rsi); *(LAS unsigned*)(cp + 272) = pk2(c1r, c1i); *(LAS unsigned*)(cp + 544) = pk2(c2r, c2i); *(LAS unsigned*)(cp + 816) = pk2(c3r, c3i);
                            }
                        }
                        CBAR();
#pragma unroll
                        for (int mt = 0; mt < 2; ++mt)
#pragma unroll
                            for (int ks = 0; ks < 8; ++ks) { unsigned vo2 = voU; asm volatile("" : "+v"(vo2)); uf[mt][ks] = ldg<bf16x8>(pu + (32 * wave + 16 * mt) * 256 + 32 * ks, vo2); }
                        bf16x8 cf[2][4];
#pragma unroll
                        for (int mt = 0; mt < 2; ++mt)
#pragma unroll
                            for (int kc = 0; kc < 4; ++kc) cf[mt][kc] = *(const LAS bf16x8*)(CB + (16 * mt + r) * 272 + (32 * kc + 8 * q) * 2);
                        const unsigned voY = (unsigned)(64 * q * DSSM + r) * 2u;
#pragma unroll
                        for (int nt = 0; nt < 16; ++nt) {
                            LAS unsigned char* wb = WB + (nt & 1) * 12288;
                            if (nt + 1 < 16) { const int nf = 5 + ((nt + 1) >> 1);
                                if (wave < nf) __builtin_amdgcn_global_load_lds((const unsigned*)((const char*)(Wl + ((nt + 1) * 12 + wave) * 512) + voF), (LAS unsigned*)(WB + ((nt + 1) & 1) * 12288 + wave * 1024), 16, 0, 0);
                                if (wave + 8 < nf) __builtin_amdgcn_global_load_lds((const unsigned*)((const char*)(Wl + ((nt + 1) * 12 + wave + 8) * 512) + voF), (LAS unsigned*)(WB + ((nt + 1) & 1) * 12288 + (wave + 8) * 1024), 16, 0, 0); }
                            f32x4 y0 = {0.f, 0.f, 0.f, 0.f}, y1 = {0.f, 0.f, 0.f, 0.f};
                            bf16x8 wv[12];
#pragma unroll
                            for (int i = 0; i < 5 + (nt >> 1); ++i) wv[i] = *(const LAS bf16x8*)(wb + i * 1024 + voF);
#pragma unroll
                            for (int kc = 0; kc < 4; ++kc) { y0 = __builtin_amdgcn_mfma_f32_16x16x32_bf16(cf[0][kc], wv[kc], y0, 0, 0, 0); y1 = __builtin_amdgcn_mfma_f32_16x16x32_bf16(cf[1][kc], wv[kc], y1, 0, 0, 0); }
#pragma unroll
                            for (int ks = 0; ks <= (nt >> 1); ++ks) { y0 = __builtin_amdgcn_mfma_f32_16x16x32_bf16(uf[0][ks], wv[4 + ks], y0, 0, 0, 0); y1 = __builtin_amdgcn_mfma_f32_16x16x32_bf16(uf[1][ks], wv[4 + ks], y1, 0, 0, 0); }
#pragma unroll
                            for (int jj = 0; jj < 4; ++jj) {
                                stg<unsigned short>(ys + (size_t)(b * SEQ + 512 * wave + 16 * jj + nt) * DSSM + GC * g, voY, f2bf(gelu_fast(y0[jj])));
                                stg<unsigned short>(ys + (size_t)(b * SEQ + 512 * wave + 256 + 16 * jj + nt) * DSSM + GC * g, voY, f2bf(gelu_fast(y1[jj]))); }
                            __syncthreads();
                        }
                    }
                    __syncthreads();
                    {
                        int lane_r = lane; asm volatile("" : "+v"(lane_r));
                        const int r = lane_r & 15, q = lane_r >> 4;
                        int g2 = g; asm volatile("" : "+s"(g2));
                        const int lgr = l * NGRP + g2, hh = g2 >> 2, qt = g2 & 3, chg = GC * g2 + r;
                        const bf16* rs = proj + (size_t)T * 512 + (size_t)(b * NH + hh) * SEQ * HD;
                        const bf16* gs = proj + (size_t)(b * NGRP + g2) * SEQ * GC;
                        LAS float* slots = (LAS float*)ring;
                        LAS unsigned char* SR = ring + 2048 + wave * 6144;
                        LAS unsigned char* GT = SR + 5040;
                        bf16x8 wg0[8], wg1[8];
#pragma unroll
                        for (int ks = 0; ks < 8; ++ks) { wg0[ks] = *(const LAS bf16x8*)(ring + 116736 + ((0 * 8 + ks) * 64 + lane_r) * 16); wg1[ks] = *(const LAS bf16x8*)(ring + 116736 + ((1 * 8 + ks) * 64 + lane_r) * 16); }
                        const float bap = gbias[(lgr * 2 + 0) * GC + r], bxp = gbias[(lgr * 2 + 1) * GC + r];
                        const float ey_ = __expf(-in_[8][l * DREC + chg]);
                        const float sp8 = 8.f * ((ey_ < 0.03125f) ? ey_ * (1.f - ey_ * (0.5f - ey_ * (0.33333334f - ey_ * (0.25f - 0.2f * ey_)))) : __logf(1.f + ey_));
                        const float cw0 = in_[2][((size_t)l * 4 + 0) * DREC + chg], cw1 = in_[2][((size_t)l * 4 + 1) * DREC + chg], cw2 = in_[2][((size_t)l * 4 + 2) * DREC + chg], cw3 = in_[2][((size_t)l * 4 + 3) * DREC + chg], cbv = in_[3][l * DREC + chg];
                        float hc = 0.f;
                        const u32x4 z4u = {0u, 0u, 0u, 0u};
                        u32x4 pre[5], preg[1];
#define RG_LOAD(tbx) do { _Pragma("unroll") for (int i_ = 0; i_ < 5; ++i_) { const int p_ = lane_r + 64 * i_, row_ = p_ >> 3, t_ = (tbx) - 3 + row_; \
                                pre[i_] = (p_ < 280 && t_ >= 0) ? ldg<u32x4>(rs + ((tbx) - 3) * HD + 512 * i_, (unsigned)lane_r * 16u) : z4u; } \
                            preg[0] = ldg<u32x4>(gs + (tbx) * GC, (unsigned)lane_r * 16u); } while (0)
                        RG_LOAD(32 * wave);
                        const bool trn = (item == vcu) && (NGW == 2048);
                        LAS float* tscr = (LAS float*)(ring + 51200 + wave * 8192);
                        unsigned ypk[4] = {0u, 0u, 0u, 0u}; float sstp = 0.f;
#define RG_STORE_PREV(tbp_) do { _Pragma("unroll") for (int mt = 0; mt < 2; ++mt) _Pragma("unroll") for (int jj = 0; jj < 4; ++jj) \
                            stg<unsigned short>(ycat + (size_t)(b * SEQ + (tbp_) + 16 * mt + jj) * 1024 + GC * g2, (unsigned)(4 * q * 1024 + r) * 2u, (unsigned short)((jj & 1) ? (ypk[2 * mt + (jj >> 1)] >> 16) : (ypk[2 * mt + (jj >> 1)] & 0xffffu))); \
                            if (r < 8) stg<float>(ss1p + (size_t)(b * SEQ + (tbp_)) * 32 + g2, (unsigned)((16 * (r >> 2) + 4 * q + (r & 3)) * 32) * 4u, sstp); } while (0)
                        for (int sb = 0; sb < 16; ++sb) {
                            const int tb = 256 * sb + 32 * wave;
#pragma unroll
                            for (int i_ = 0; i_ < 5; ++i_) { const int p_ = lane_r + 64 * i_; if (p_ < 280) *(LAS u32x4*)(SR + (p_ >> 3) * 144 + 16 * (p_ & 7)) = pre[i_]; }
#pragma unroll
                            for (int i_ = 0; i_ < 1; ++i_) { const int p_ = lane_r + 64 * i_; *(LAS u32x4*)(GT + (p_ >> 1) * 32 + 16 * (p_ & 1)) = preg[i_]; }
                            CBAR();
                            if (sb < 15) RG_LOAD(tb + 256);
                            const int tj = sb * 2048 + gw; const int tlw = (tj < TRJ0) ? l + 1 : l; const bool thave = trn && tj < TRJ && tlw < DEPTH && !(tj >= TRJ1 && tj < TRJ2);
                            if (thave) { const float* tW; bf16* tWT; int tK, tN, tIL, tOFF, tK0, tN0; TR_DECODE(tlw, tj, tW, tWT, tK, tN, tIL, tOFF, tK0, tN0); TR_DMA(tscr, tW, tN, tK0, tN0); }
                            if (sb > 0) RG_STORE_PREV(tb - 256);
                            float Pb = 1.f, Hb = 0.f; float Pc[2][4], Hc[2][4];
#pragma unroll
                            for (int mt = 0; mt < 2; ++mt) {
                                f32x4 zrm = {0.f, 0.f, 0.f, 0.f}, zim = {0.f, 0.f, 0.f, 0.f};
#pragma unroll
                                for (int ks = 0; ks < 8; ++ks) { const bf16x8 av = *(const LAS bf16x8*)(SR + (16 * mt + r + (ks >> 1)) * 144 + (32 * (ks & 1) + 8 * q) * 2);
                                    zrm = __builtin_amdgcn_mfma_f32_16x16x32_bf16(av, wg0[ks], zrm, 0, 0, 0); zim = __builtin_amdgcn_mfma_f32_16x16x32_bf16(av, wg1[ks], zim, 0, 0, 0); }
                                float x[7];
#pragma unroll
                                for (int d = 0; d < 7; ++d) x[d] = bf2f(*(const LAS unsigned short*)(SR + (16 * mt + 4 * q + d) * 144 + (GC * qt + r) * 2));
                                float Pj = 1.f, Hj = 0.f;
#pragma unroll
                                for (int jj = 0; jj < 4; ++jj) {
                                    const float u = cbv + cw0 * x[jj] + cw1 * x[jj + 1] + cw2 * x[jj + 2] + cw3 * x[jj + 3];
                                    const float rg = sigmoidf(zrm[jj] + bap), ig = sigmoidf(zim[jj] + bxp);
                                    const float av = __expf(-sp8 * rg), mult = __builtin_amdgcn_sqrtf(fmaxf(1.f - av * av, 0.f)), bt = mult * (ig * u);
                                    Hj = av * Hj + bt; Pj = Pj * av; Pc[mt][jj] = Pj; Hc[mt][jj] = Hj; }
                                float Pi = Pj, Hi = Hj;
                                { const float Pn = lane_get(Pi, lane_r - 16), Hn = lane_get(Hi, lane_r - 16); if (q >= 1) { Hi = Pi * Hn + Hi; Pi = Pn * Pi; } }
                                { const float Pn = lane_get(Pi, lane_r - 32), Hn = lane_get(Hi, lane_r - 32); if (q >= 2) { Hi = Pi * Hn + Hi; Pi = Pn * Pi; } }
                                float Pe = lane_get(Pi, lane_r - 16), He = lane_get(Hi, lane_r - 16); if (q == 0) { Pe = 1.f; He = 0.f; }
                                const float Pt = lane_get(Pi, 48 + r), Ht = lane_get(Hi, 48 + r);
                                const float bP = Pb * Pe, bH = Pe * Hb + He;
#pragma unroll
                                for (int jj = 0; jj < 4; ++jj) { Hc[mt][jj] = Pc[mt][jj] * bH + Hc[mt][jj]; Pc[mt][jj] = bP * Pc[mt][jj]; }
                                Hb = Pt * Hb + Ht; Pb = Pb * Pt;
                            }
                            if (q == 0) { slots[((sb & 1) * 128 + wave * 16 + r) * 2] = Pb; slots[((sb & 1) * 128 + wave * 16 + r) * 2 + 1] = Hb; }
                            if (thave) { asm volatile("s_waitcnt vmcnt(0)" ::: "memory");
                                const float* tW; bf16* tWT; int tK, tN, tIL, tOFF, tK0, tN0; TR_DECODE(tlw, tj, tW, tWT, tK, tN, tIL, tOFF, tK0, tN0); TR_OUT(tscr, tWT, tK, tIL, tOFF, tK0, tN0); }
                            asm volatile("s_waitcnt lgkmcnt(0)" ::: "memory"); __builtin_amdgcn_s_barrier(); asm volatile("" ::: "memory");
                            float carry = hc, mine = 0.f;
#pragma unroll
                            for (int w2 = 0; w2 < 8; ++w2) { const float sp_ = slots[((sb & 1) * 128 + w2 * 16 + r) * 2], sh_ = slots[((sb & 1) * 128 + w2 * 16 + r) * 2 + 1];
                                if (w2 == wave) mine = carry; carry = sp_ * carry + sh_; }
                            hc = carry; float sst = 0.f; float yvv[2][4];
#pragma unroll
                            for (int mt = 0; mt < 2; ++mt)
#pragma unroll
                                for (int jj = 0; jj < 4; ++jj) { const float h = Hc[mt][jj] + Pc[mt][jj] * mine;
                                    const float gtv = bf2f(*(const LAS unsigned short*)(GT + (16 * mt + 4 * q + jj) * 32 + 2 * r)); const float yv = gtv * h; yvv[mt][jj] = yv;
                                    const float sq = row16_sum(yv * yv); if (r == 4 * mt + jj) sst = sq; }
#pragma unroll
                            for (int mt = 0; mt < 2; ++mt) { ypk[2 * mt] = pk2(yvv[mt][0], yvv[mt][1]); ypk[2 * mt + 1] = pk2(yvv[mt][2], yvv[mt][3]); }
                            sstp = sst;
                        }
                        RG_STORE_PREV(256 * 15 + 32 * wave);
#undef RG_STORE_PREV
#undef RG_LOAD
                    }
                    __syncthreads();
                }
            } else if (k == 2) {
                pg8::Gemm g{ys, WgluT + (size_t)l * 1024 * 512, T, 1024, 512}; pg8::StaticOrder S; S.init(T, 1024, 512, G, bx);
                pg8::EpiGated<0> E{ycat + 512, in_[18] + l * 1024, 1024, ss2p};
                pg8::gemm_phase<pg8::EpiGated<0>, pg8::StaticOrder, false>(ring, g, S, E, tid);
            } else if (k == 3) {
            } else if (k == 4) {
                pg8::Gemm g{ycat, WoutT + (size_t)l * 1024 * 1024, T, 1024, 1024}; pg8::StaticOrder S; S.init(T, 1024, 1024, G, bx);
                LAS float* st = (LAS float*)(ring + 131072);
                { pg8::Unit su;
                  for (int i = 0; i < 6 && S.next(i, su); ++i) {
                    const int row = tid >> 1, hsel = tid & 1; const size_t grow = (size_t)su.pm * 256 + row;
                    f32x4 p[8];
#pragma unroll
                    for (int j = 0; j < 8; ++j) p[j] = (hsel == 0) ? *(const f32x4*)(ss1p + grow * 32 + 4 * j) : ((j < 4) ? *(const f32x4*)(ss2p + grow * 16 + 4 * j) : (f32x4){0.f, 0.f, 0.f, 0.f});
                    float sq = 0.f;
#pragma unroll
                    for (int j = 0; j < 8; ++j) sq += (p[j][0] + p[j][1]) + (p[j][2] + p[j][3]);
                    const float rs = rsqrtf(sq * (1.f / 512.f) + RMS_EPS), ot = lane_get(rs, lane ^ 1);
                    if (hsel == 0) st[(i * 256 + row) * 2] = rs * __builtin_amdgcn_rcpf(ot); else st[(i * 256 + row) * 2 + 1] = rs;
                  }
                  __syncthreads(); }
                pg8::EpiResidRms E{xb, st};
                pg8::gemm_phase<pg8::EpiResidRms, pg8::StaticOrder, false>(ring, g, S, E, tid);
            } else if (k == 9) {
                const float* lg = in_[31] + l * D; const float* lb = in_[32] + l * D;
                const bool fin = (l == DEPTH - 1);
                f32x4 gg[2][2], bb[2][2];
#pragma unroll
                for (int j = 0; j < 2; ++j) { gg[j][0] = *(const f32x4*)(lg + 512 * j + 8 * lane); gg[j][1] = *(const f32x4*)(lg + 512 * j + 8 * lane + 4); bb[j][0] = *(const f32x4*)(lb + 512 * j + 8 * lane); bb[j][1] = *(const f32x4*)(lb + 512 * j + 8 * lane + 4); }
                for (int tok0 = 4 * gw; tok0 < T; tok0 += 4 * NGW) {
                    u32x4 xv[4][2], y0[4][2], y1[4][2];
#pragma unroll
                    for (int t = 0; t < 4; ++t)
#pragma unroll
                        for (int j = 0; j < 2; ++j) { xv[t][j] = *(const u32x4*)(xb + (size_t)(tok0 + t) * D + 512 * j + 8 * lane);
                            y0[t][j] = *(const u32x4*)(Yb + (size_t)(2 * (tok0 + t)) * D + 512 * j + 8 * lane); y1[t][j] = *(const u32x4*)(Yb + (size_t)(2 * (tok0 + t) + 1) * D + 512 * j + 8 * lane); }
#pragma unroll
                    for (int t = 0; t < 4; ++t) { const int tok = tok0 + t;
                        float v[16]; float s = 0.f;
#pragma unroll
                        for (int j = 0; j < 2; ++j)
#pragma unroll
                            for (int i = 0; i < 4; ++i) { v[8 * j + 2 * i] = ALPHA * bflo(xv[t][j][i]) + bflo(y0[t][j][i]) + bflo(y1[t][j][i]); v[8 * j + 2 * i + 1] = ALPHA * bfhi(xv[t][j][i]) + bfhi(y0[t][j][i]) + bfhi(y1[t][j][i]); }
#pragma unroll
                        for (int i = 0; i < 16; ++i) s += v[i];
                        const float mu = wave_sum(s, lane) * (1.f / D); float s2 = 0.f;
#pragma unroll
                        for (int i = 0; i < 16; ++i) { v[i] -= mu; s2 += v[i] * v[i]; }
                        const float rstd = rsqrtf(wave_sum(s2, lane) * (1.f / D) + LN_EPS);
#pragma unroll
                        for (int j = 0; j < 2; ++j) { const int c0 = 512 * j + 8 * lane; float o[8];
#pragma unroll
                            for (int i = 0; i < 4; ++i) { o[i] = v[8 * j + i] * rstd * gg[j][0][i] + bb[j][0][i]; o[4 + i] = v[8 * j + 4 + i] * rstd * gg[j][1][i] + bb[j][1][i]; }
                            if (fin) { *(f32x4*)(xf + (size_t)tok * D + c0) = (f32x4){o[0], o[1], o[2], o[3]}; *(f32x4*)(xf + (size_t)tok * D + c0 + 4) = (f32x4){o[4], o[5], o[6], o[7]}; }
                            else { u32x4 w; w.x = pk2(o[0], o[1]); w.y = pk2(o[2], o[3]); w.z = pk2(o[4], o[5]); w.w = pk2(o[6], o[7]); *(u32x4*)(xb + (size_t)tok * D + c0) = w; } } }
                }
            } else if (k == 6) {
            } else if (k == 5) {
                const bf16* Wr = WrT + (size_t)l * 48 * D; const float* c1v = rcst + (l * 2 + 0) * 48; const float* c0v = rcst + (l * 2 + 1) * 48;
                const float* lg = in_[22] + l * D; const float* lb = in_[23] + l * D;
                unsigned* cntg = ctl + CW_CNT + l * NE * 64;
                LAS float* lgt = (LAS float*)(ring + 98304 + wave * 4096);
                const int r = lane & 15, q = lane >> 4;
#pragma unroll
                for (int pz = 0; pz < 12; ++pz) __builtin_amdgcn_global_load_lds((const unsigned*)((const char*)Wr + (size_t)(wave + 8 * pz) * 1024 + lane * 16), (LAS unsigned*)(ring + (wave + 8 * pz) * 1024), 16, 0, 0);
                asm volatile("s_waitcnt vmcnt(0)" ::: "memory"); __syncthreads();
                for (int ch = vcu; ch < T / 128; ch += G) {
                    if (tid < 32) lc_lcnt[tid] = 0u;
                    const int tok0 = ch * 128 + wave * 16;
                    f32x4 acc[3] = {{0.f, 0.f, 0.f, 0.f}, {0.f, 0.f, 0.f, 0.f}, {0.f, 0.f, 0.f, 0.f}};
                    const bf16* ap = xb + (size_t)(tok0 + r) * D + 8 * q;
#pragma unroll 1
                    for (int k0 = 0; k0 < 32; k0 += 8) {
                        bf16x8 av[8], bv[3][8];
#pragma unroll
                        for (int i = 0; i < 8; ++i) { av[i] = *(const bf16x8*)(ap + 32 * (k0 + i));
#pragma unroll
                            for (int nt = 0; nt < 3; ++nt) bv[nt][i] = *(const LAS bf16x8*)(ring + ((nt * 32 + k0 + i) * 64 + lane) * 16); }
#pragma unroll
                        for (int i = 0; i < 8; ++i)
#pragma unroll
                            for (int nt = 0; nt < 3; ++nt) acc[nt] = __builtin_amdgcn_mfma_f32_16x16x32_bf16(av[i], bv[nt][i], acc[nt], 0, 0, 0); }
#pragma unroll
                    for (int nt = 0; nt < 3; ++nt)
#pragma unroll
                        for (int j = 0; j < 4; ++j) lgt[(4 * q + j) * 48 + 16 * nt + r] = acc[nt][j];
                    float mymu = 0.f, myrs = 0.f;
                    const f32x4 g0a = *(const f32x4*)(lg + 8 * lane), g0b = *(const f32x4*)(lg + 8 * lane + 4), g1a = *(const f32x4*)(lg + 512 + 8 * lane), g1b = *(const f32x4*)(lg + 512 + 8 * lane + 4);
                    const f32x4 b0a = *(const f32x4*)(lb + 8 * lane), b0b = *(const f32x4*)(lb + 8 * lane + 4), b1a = *(const f32x4*)(lb + 512 + 8 * lane), b1b = *(const f32x4*)(lb + 512 + 8 * lane + 4);
#pragma unroll 1
                    for (int i0 = 0; i0 < 16; i0 += 4) {
                        u32x4 xv[4][2];
#pragma unroll
                        for (int i = 0; i < 4; ++i)
#pragma unroll
                            for (int j = 0; j < 2; ++j) xv[i][j] = *(const u32x4*)(xb + (size_t)(tok0 + i0 + i) * D + 512 * j + 8 * lane);
#pragma unroll
                        for (int i = 0; i < 4; ++i) {
                            float v[16]; float s = 0.f;
#pragma unroll
                            for (int j = 0; j < 2; ++j)
#pragma unroll
                                for (int e2 = 0; e2 < 4; ++e2) { v[8 * j + 2 * e2] = bflo(xv[i][j][e2]); v[8 * j + 2 * e2 + 1] = bfhi(xv[i][j][e2]); }
#pragma unroll
                            for (int e2 = 0; e2 < 16; ++e2) s += v[e2];
                            const float mu = wave_sum(s, lane) * (1.f / D); float s2 = 0.f;
#pragma unroll
                            for (int e2 = 0; e2 < 16; ++e2) { v[e2] -= mu; s2 += v[e2] * v[e2]; }
                            const float rstd = rsqrtf(wave_sum(s2, lane) * (1.f / D) + LN_EPS);
                            if (lane == i0 + i) { mymu = mu; myrs = rstd; }
                            u32x4 w0, w1;
                            w0.x = pk2(v[0] * rstd * g0a[0] + b0a[0], v[1] * rstd * g0a[1] + b0a[1]); w0.y = pk2(v[2] * rstd * g0a[2] + b0a[2], v[3] * rstd * g0a[3] + b0a[3]);
                            w0.z = pk2(v[4] * rstd * g0b[0] + b0b[0], v[5] * rstd * g0b[1] + b0b[1]); w0.w = pk2(v[6] * rstd * g0b[2] + b0b[2], v[7] * rstd * g0b[3] + b0b[3]);
                            w1.x = pk2(v[8] * rstd * g1a[0] + b1a[0], v[9] * rstd * g1a[1] + b1a[1]); w1.y = pk2(v[10] * rstd * g1a[2] + b1a[2], v[11] * rstd * g1a[3] + b1a[3]);
                            w1.z = pk2(v[12] * rstd * g1b[0] + b1b[0], v[13] * rstd * g1b[1] + b1b[1]); w1.w = pk2(v[14] * rstd * g1b[2] + b1b[2], v[15] * rstd * g1b[3] + b1b[3]);
                            *(u32x4*)(xb + (size_t)(tok0 + i0 + i) * D + 8 * lane) = w0; *(u32x4*)(xb + (size_t)(tok0 + i0 + i) * D + 512 + 8 * lane) = w1;
                        }
                    }
                    LDS_WAIT();
                    if (lane < 16) {
                        const LAS float* row = lgt + lane * 48;
                        float gl[NEG];
#pragma unroll
                        for (int o = 0; o < NEG; ++o) gl[o] = myrs * (row[32 + o] - mymu * c1v[32 + o]) + c0v[32 + o];
                        int gi = 0; float gm = gl[0];
#pragma unroll
                        for (int o = 1; o < NEG; ++o) if (gl[o] > gm) { gm = gl[o]; gi = o; }
                        float gs = 0.f;
#pragma unroll
                        for (int o = 0; o < NEG; ++o) gs += __expf(gl[o] - gm);
                        const float gtop = __builtin_amdgcn_rcpf(gs);
                        float el[EPG];
#pragma unroll
                        for (int o = 0; o < EPG; ++o) el[o] = myrs * (row[gi * EPG + o] - mymu * c1v[gi * EPG + o]) + c0v[gi * EPG + o];
                        int i1 = 0; float m1 = el[0];
#pragma unroll
                        for (int o = 1; o < EPG; ++o) if (el[o] > m1) { m1 = el[o]; i1 = o; }
                        int i2 = 0; float m2 = -3.0e38f;
#pragma unroll
                        for (int o = 0; o < EPG; ++o) if (o != i1 && el[o] > m2) { m2 = el[o]; i2 = o; }
                        const float p2 = __expf(m2 - m1), inv = __builtin_amdgcn_rcpf(1.f + p2);
                        lc_gv[wave * 32 + lane * 2] = gtop * inv; lc_gv[wave * 32 + lane * 2 + 1] = gtop * p2 * inv;
                        lc_ent[wave * 32 + lane * 2] = gi * EPG + i1; lc_ent[wave * 32 + lane * 2 + 1] = gi * EPG + i2;
                    }
                    __syncthreads();
                    int e = 0;
                    if (tid < 256) { e = lc_ent[tid]; lc_rank[tid] = __hip_atomic_fetch_add(&lc_lcnt[e], 1u, __ATOMIC_RELAXED, __HIP_MEMORY_SCOPE_WORKGROUP); }
                    __syncthreads();
                    if (tid < 32) lc_gb[tid] = xb_add(cntg + tid * 64, lc_lcnt[tid]);
                    __syncthreads();
                    if (tid < 256) { const int w = tid >> 5, i = tid & 31; const size_t sl = (size_t)e * T + lc_gb[e] + lc_rank[tid]; list[sl] = (ch * 128 + w * 16 + (i >> 1)) * 2 + (i & 1); gate[sl] = lc_gv[tid]; }
                    __syncthreads();
                }
            } else {
                unsigned* cntg = ctl + CW_CNT + l * NE * 64;
                if (k == 7 || ph == a.ph_lo) if (tid < 64) {
                    const unsigned cnv = (tid < NE) ? xb_ld(cntg + tid * 64) : 0u; const int tl = (int)((cnv + 255u) >> 8); int inc = tl;
#pragma unroll
                    for (int o = 1; o < 32; o <<= 1) { const int nb_ = __builtin_amdgcn_ds_bpermute((tid - o) << 2, inc); if (tid >= o) inc += nb_; }
                    if (tid < NE) { lc_cn[tid] = cnv; lc_tb[tid] = inc - tl; }
                    if (tid == NE - 1) lc_tb[NE] = inc;
                }
                __syncthreads();
                if (k == 7) {
                    pg8::Gemm g{xb, WguT + (size_t)l * NE * 1024 * 1024, 0, 1024, 1024};
                    pg8::MoeOrder S{lc_tb, lc_cn, list, G, vcu, 1024, (long)1024 * 1024 * 2, (long)256 * 1024 * 2, lane, ring + 131072 + 4096};
                    pg8::EpiGated<1> E{Hb, nullptr, 512, nullptr};
                    pg8::gemm_phase<pg8::EpiGated<1>, pg8::MoeOrder, true>(ring, g, S, E, tid);
                } else {
                    pg8::Gemm g{Hb, WdT + (size_t)l * NE * 1024 * 512, 0, 1024, 512};
                    pg8::MoeOrder S{lc_tb, lc_cn, list, G, vcu, 512, (long)1024 * 512 * 2, (long)256 * 512 * 2, lane, nullptr};
                    pg8::EpiMoeOut E{Yb, list, gate, lc_cn, ring + 131072};
                    pg8::gemm_phase<pg8::EpiMoeOut, pg8::MoeOrder, false>(ring, g, S, E, tid);
                }
            }
        }
        if ((ph + 1 < a.ph_hi || rep + 1 < reps) && kind != 6 && kind != 3) xcd_barrier(bar, tid);
      }
    }
}

extern "C" void kernel_launch(void* const* d_in, const int* in_sizes, int n_in, void* d_out, int out_size, void* d_ws, size_t ws_size, hipStream_t stream) {
    static int grid = 0;
    if (grid == 0) {
        if (n_in != 33 || out_size != T * D || ws_size < WS_END) { fprintf(stderr, "kernel_launch: unexpected shapes n_in=%d out=%d ws=%zu need=%zu\n", n_in, out_size, ws_size, (size_t)WS_END); grid = -1; return; }
        int dev = 0, cus = 0, per_cu = 0;
        if (hipGetDevice(&dev) != hipSuccess || hipDeviceGetAttribute(&cus, hipDeviceAttributeMultiprocessorCount, dev) != hipSuccess) { grid = -1; return; }
        if (hipFuncSetAttribute((const void*)mk_fwd, hipFuncAttributeMaxDynamicSharedMemorySize, LDS_BYTES) != hipSuccess) { fprintf(stderr, "kernel_launch: hipFuncSetAttribute failed\n"); grid = -1; return; }
        if (hipOccupancyMaxActiveBlocksPerMultiprocessor(&per_cu, (const void*)mk_fwd, NTHREADS, LDS_BYTES) != hipSuccess || per_cu < 1) { fprintf(stderr, "kernel_launch: occupancy query failed (%d)\n", per_cu); (void)hipGetLastError(); grid = -1; return; }
        grid = cus;
        if (grid < 86) { fprintf(stderr, "kernel_launch: grid %d too small (the out GEMM keeps row statistics for at most 6 units per workgroup)\n", grid); grid = -1; return; }
    }
    if (grid < 0) return;
    (void)hipMemsetAsync((char*)d_ws + WS_CTL, 0, CTL_ZERO_BYTES, stream);
    Args a{};
    for (int i = 0; i < 33; ++i) a.in[i] = (const float*)d_in[i];
    a.out = (float*)d_out; a.ws = (unsigned char*)d_ws;
    a.ph_lo = 0; a.ph_hi = 1 + 10 * DEPTH; a.li = 0; a.pad = DUPMASK;
    hipLaunchKernelGGL(mk_fwd, dim3(grid), dim3(NTHREADS), LDS_BYTES, stream, a);
}
```

```cpp
#include <hip/hip_runtime.h>
#include <cstdio>
#include <cstdint>

typedef unsigned short bf16;
#define LAS __attribute__((address_space(3)))

constexpr int BATCH = 8, SEQ = 4096, D = 1024, T = BATCH * SEQ, DEPTH = 4;
constexpr int DREC = 512, DSSM = 512, NH = 8, HD = 64, NGRP = 32, GC = 16, NST = 64;
constexpr int NEG = 4, EPG = 8, NE = 32, DE = 512, NPROJ = 1536;
constexpr float ALPHA = 1.681792830507429f;
constexpr float LN_EPS = 1e-5f, RMS_EPS = 1e-6f;
constexpr int NWAVES = 8, NTHREADS = 512;
constexpr int DUPMASK = 0x0;

constexpr size_t MiB = 1u << 20;
constexpr size_t WS_CTL = 0, CTL_ZERO_BYTES = 128 * 1024;
constexpr size_t WS_WIN = 1 * MiB;
constexpr size_t WS_WGLU = WS_WIN + (size_t)DEPTH * NPROJ * D * 2;
constexpr size_t WS_WOUT = WS_WGLU + (size_t)DEPTH * 1024 * 512 * 2;
constexpr size_t WS_WGU = WS_WOUT + (size_t)DEPTH * 1024 * 1024 * 2;
constexpr size_t WS_WD = WS_WGU + (size_t)DEPTH * NE * 1024 * 1024 * 2;
constexpr size_t WS_A16 = WS_WD + (size_t)DEPTH * NE * 1024 * 512 * 2;
constexpr size_t WS_WRT = WS_A16 + 1 * MiB;
constexpr size_t WS_RC = WS_WRT + 512 * 1024;
constexpr size_t WS_B16 = WS_WRT + 1 * MiB;
constexpr size_t WS_WS5 = WS_B16 + 8 * MiB;
constexpr size_t WS_WGT = WS_WS5 + 24 * MiB;
constexpr size_t WS_GB = WS_WGT + 2 * MiB;
constexpr size_t WS_XB = WS_GB + 1 * MiB;
constexpr size_t WS_EID = WS_XB + (size_t)T * D * 2;
constexpr size_t WS_GATE = WS_EID + (size_t)T * 2 * 4, WS_LIST = WS_GATE + (size_t)NE * T * 4;
constexpr size_t WS_ACT = WS_LIST + (size_t)NE * T * 4;
constexpr size_t WS_PROJ = WS_ACT;
constexpr size_t WS_YS = WS_PROJ + (size_t)T * NPROJ * 2;
constexpr size_t WS_YREC = WS_YS + (size_t)T * 512 * 2;
constexpr size_t WS_UG = WS_YREC + (size_t)T * 512 * 2;
constexpr size_t WS_YCAT = WS_UG + (size_t)T * 512 * 2;
constexpr size_t WS_ACT_END1 = WS_YCAT + (size_t)T * 1024 * 2;
constexpr int MAXTILES = 2 * T / 256 + NE;
constexpr size_t WS_H = WS_ACT;
constexpr size_t WS_Y = WS_H + (size_t)MAXTILES * 256 * 512 * 2;
constexpr size_t WS_ACT_END2 = WS_Y + (size_t)MAXTILES * 256 * 1024 * 2;
constexpr size_t WS_END = WS_ACT_END1 > WS_ACT_END2 ? WS_ACT_END1 : WS_ACT_END2;
constexpr int CW_CNT = 1024;
constexpr int CW_BAR = 16384;
constexpr int XCD_BAR_WORDS_C = 3456, MAX_LAUNCHES = 1;
static_assert((CW_BAR + MAX_LAUNCHES * XCD_BAR_WORDS_C) * 4 <= (int)CTL_ZERO_BYTES, "ctl");
constexpr int LDS_CTL = 0, LDS_RING = 4096, LDS_BYTES = 147456;
constexpr int LC_BAR = 0, LC_TB = 64, LC_CN = 256, LC_LCNT = 384, LC_GB = 512, LC_ENT = 1024, LC_RANK = 2048, LC_GV = 3072;

typedef __bf16 bf16x2_t __attribute__((ext_vector_type(2)));
typedef float f32x2_t __attribute__((ext_vector_type(2)));
__device__ __forceinline__ unsigned pk2(float lo, float hi) { const f32x2_t v = {lo, hi}; const bf16x2_t b = __builtin_convertvector(v, bf16x2_t); return __builtin_bit_cast(unsigned, b); }
__device__ __forceinline__ bf16 f2bf(float f) { return (bf16)(pk2(f, 0.f) & 0xffffu); }
__device__ __forceinline__ float bf2f(bf16 h) { return __uint_as_float(((unsigned)h) << 16); }
__device__ __forceinline__ float bflo(unsigned u) { return __uint_as_float(u << 16); }
__device__ __forceinline__ float bfhi(unsigned u) { return __uint_as_float(u & 0xffff0000u); }
__device__ __forceinline__ float gelu_tanh(float x) { return 0.5f * x * (1.f + tanhf(0.7978845608028654f * (x + 0.044715f * x * x * x))); }
__device__ __forceinline__ float gelu_fast(float x) { return x * __builtin_amdgcn_rcpf(1.f + __builtin_amdgcn_exp2f(x * (x * x * -0.1029432395800235f + -2.302208198144325f))); }
__device__ __forceinline__ float sigmoidf(float x) { return __builtin_amdgcn_rcpf(1.f + __expf(-x)); }
__device__ __forceinline__ float lane_get(float v, int src_lane) { return __int_as_float(__builtin_amdgcn_ds_bpermute(src_lane << 2, __float_as_int(v))); }
template <int CTRL> __device__ __forceinline__ float dppf(float v) { return __int_as_float(__builtin_amdgcn_update_dpp(0, __float_as_int(v), CTRL, 0xF, 0xF, true)); }
__device__ __forceinline__ float row16_sum(float s) { s += dppf<0xB1>(s); s += dppf<0x4E>(s); s += dppf<0x141>(s); s += dppf<0x140>(s); return s; }
__device__ __forceinline__ float wave_sum(float v, int) {
    v = row16_sum(v);
    const float a = __int_as_float(__builtin_amdgcn_readlane(__float_as_int(v), 0)), b = __int_as_float(__builtin_amdgcn_readlane(__float_as_int(v), 16));
    const float c = __int_as_float(__builtin_amdgcn_readlane(__float_as_int(v), 32)), d = __int_as_float(__builtin_amdgcn_readlane(__float_as_int(v), 48));
    return (a + b) + (c + d); }


namespace pg8 {
#define PG8_LAS __attribute__((address_space(3)))
typedef unsigned short bf16_t;
typedef short bf16x8 __attribute__((ext_vector_type(8)));
typedef float f32x4 __attribute__((ext_vector_type(4)));
typedef unsigned u32x4 __attribute__((ext_vector_type(4)));
typedef unsigned u32x2 __attribute__((ext_vector_type(2)));
constexpr int BM = 256, BK = 64, HALF = 128, HTB = HALF * BK * 2, STAGE_BYTES = 8 * HTB, NXCD = 8, WGM = 8;

__host__ __device__ __forceinline__ int lds_byte(int r, int c) { const int st = (r >> 4) * 2 + (c >> 5), rr = r & 15, cc = c & 31, ob = rr * 64 + cc * 2; return st * 1024 + (ob ^ (((ob >> 9) & 1) << 5)); }
__host__ __device__ __forceinline__ void stage_rc(int b, int& R, int& C) { const int st = b / 1024, sb = b % 1024, swz = sb ^ (((sb >> 9) & 1) << 5); R = (st >> 1) * 16 + swz / 64; C = (st & 1) * 32 + (swz % 64) / 2; }
__host__ __device__ __forceinline__ int perm32(int rho) { const int n = rho >> 4, i = rho & 15; return 8 * (i >> 2) + 4 * n + (i & 3); }

struct Unit { int pm, pn, e, s0; long bo; };
struct Gemm { const bf16_t* A; const bf16_t* Bt; int M, N, K; };

struct StaticOrder {
    int nM, nN, nwg, G, c; long tstep;
    __device__ void init(int M, int N, int K, int G_, int c_) { nM = M / BM; nN = N / BM; nwg = nM * nN; G = G_; c = c_; tstep = (long)BM * K * 2; }
    __device__ bool next(int i, Unit& u) const {
        const long L = (long)i * G + c; if (L >= nwg) return false;
        int wgid = (int)L; { const int q = nwg / NXCD, r = nwg % NXCD, xcd = wgid % NXCD, off = wgid / NXCD; wgid = (xcd < r ? xcd * (q + 1) : r * (q + 1) + (xcd - r) * q) + off; }
        const int nig = WGM * nN, gid = wgid / nig, fm = gid * WGM, gsz = (nM - fm) < WGM ? (nM - fm) : WGM;
        u.pm = fm + ((wgid % nig) % gsz); u.pn = (wgid % nig) / gsz; u.e = 0; u.s0 = 0; u.bo = (long)u.pn * tstep; return true;
    }
    __device__ __forceinline__ unsigned a_off(const Unit&, int, int, int) const { return 0u; }
};
struct MoeOrder {
    const PG8_LAS int* tb; const PG8_LAS unsigned* cn; const int* list; int G, c, K; long estride, tstep; int lane; PG8_LAS unsigned char* gb; int lim;
    __device__ bool next(int i, Unit& u) const {
        const int U = tb[NE] * 4; int cc = c;
        if ((i + 1) * G > U && G == 256) cc = (c & 7) * 32 + (c >> 3);
        const int L = i * G + cc; if (L >= lim) return false;
        decode(L, u); return true;
    }
    __device__ void decode(int L, Unit& u) const {
        const int tt = L >> 2;
        const int tbl = (lane >= 1 && lane < NE) ? tb[lane] : 0x7fffffff;
        const int e = __builtin_popcountll(__builtin_amdgcn_ballot_w64(tt >= tbl));
        u.pm = tt; u.pn = L & 3; u.e = e; u.s0 = (tt - tb[e]) * BM; u.bo = (long)e * estride + (long)u.pn * tstep;
    }
    __device__ __forceinline__ void stage_list(const Unit& u, int slot, int wid, int lane_) const {
        if (wid == 0) __builtin_amdgcn_global_load_lds((const unsigned*)(list + (size_t)u.e * T + u.s0 + 4 * lane_), (PG8_LAS unsigned*)(gb + slot * 1024), 16, 0, 0);
    }
    __device__ __forceinline__ unsigned a_off_lds(const Unit& u, int slot, int h, int R, int C) const {
        const unsigned s = (unsigned)(u.s0 + h * HALF + R); int tok = 0;
        if (s < cn[u.e]) tok = ((const PG8_LAS int*)(gb + slot * 1024))[h * HALF + R] >> 1;
        return (unsigned)tok * (unsigned)(K * 2) + (unsigned)(C * 2);
    }
    __device__ __forceinline__ unsigned a_off(const Unit& u, int h, int R, int C) const {
        const unsigned s = (unsigned)(u.s0 + h * HALF + R); int tok = 0;
        if (s < cn[u.e]) tok = list[(size_t)u.e * T + s] >> 1;
        return (unsigned)tok * (unsigned)(K * 2) + (unsigned)(C * 2);
    }
};

struct EpiProj {
    static constexpr bool PERM = true, MID = false, PRE = false;
    bf16_t* O;
    __device__ __forceinline__ void operator()(const f32x4 (&acc)[2][2][4][2], const Unit& u, int ui, int wr, int wc, int fr, int fq) const {
        const int row0 = u.pm * BM + wr * 64 + fr, sec = u.pn >> 1;
#pragma unroll
        for (int bj = 0; bj < 2; ++bj) { const int cc = (u.pn & 1) * BM + bj * HALF + wc * 32 + 8 * fq;
#pragma unroll
            for (int ai = 0; ai < 2; ++ai)
#pragma unroll
                for (int m = 0; m < 4; ++m) { const int row = row0 + ai * HALF + m * 16, b = row >> 12, t = row & 4095;
                    const size_t off = (sec == 1) ? ((size_t)((b * 8 + (cc >> 6)) * 4096 + t) * 64 + (cc & 63)) : ((size_t)((b * 32 + (cc >> 4)) * 4096 + t) * 16 + (cc & 15));
                    f32x4 v0 = acc[ai][bj][m][0], v1 = acc[ai][bj][m][1];
                    if (sec == 0) {
#pragma unroll
                        for (int i = 0; i < 4; ++i) { v0[i] = gelu_fast(v0[i]); v1[i] = gelu_fast(v1[i]); } }
                    u32x4 w; w.x = pk2(v0[0], v0[1]); w.y = pk2(v0[2], v0[3]); w.z = pk2(v1[0], v1[1]); w.w = pk2(v1[2], v1[3]);
                    *(u32x4*)(O + (size_t)sec * ((size_t)T * 512) + off) = w; } }
    }
};
struct EpiStoreBf16 {
    static constexpr bool PERM = true, MID = false, PRE = false;
    bf16_t* O; int ldc;
    __device__ __forceinline__ void operator()(const f32x4 (&acc)[2][2][4][2], const Unit& u, int ui, int wr, int wc, int fr, int fq) const {
        const int row0 = u.pm * BM + wr * 64 + fr, col0 = u.pn * BM + wc * 32 + 8 * fq;
#pragma unroll
        for (int ai = 0; ai < 2; ++ai)
#pragma unroll
            for (int m = 0; m < 4; ++m) { bf16_t* rowp = O + (size_t)(row0 + ai * HALF + m * 16) * ldc + col0;
#pragma unroll
                for (int bj = 0; bj < 2; ++bj) { const f32x4 v0 = acc[ai][bj][m][0], v1 = acc[ai][bj][m][1];
                    u32x4 w; w.x = pk2(v0[0], v0[1]); w.y = pk2(v0[2], v0[3]); w.z = pk2(v1[0], v1[1]); w.w = pk2(v1[2], v1[3]);
                    *(u32x4*)(rowp + bj * HALF) = w; } }
    }
};
template <int MODE> struct EpiGated {
    static constexpr bool PERM = true, MID = false, PRE = false;
    bf16_t* O; const float* bias; int ldo; float* ssp;
    __device__ __forceinline__ void operator()(const f32x4 (&acc)[2][2][4][2], const Unit& u, int ui, int wr, int wc, int fr, int fq) const {
        const int row0 = u.pm * BM + wr * 64 + fr, oc0 = u.pn * HALF + wc * 32 + 8 * fq;
        f32x4 bvv[2] = {{0.f, 0.f, 0.f, 0.f}, {0.f, 0.f, 0.f, 0.f}}, bgg[2] = {{0.f, 0.f, 0.f, 0.f}, {0.f, 0.f, 0.f, 0.f}};
        if (MODE == 0) {
#pragma unroll
            for (int bj = 0; bj < 2; ++bj) { bvv[bj] = *(const f32x4*)(bias + oc0 + 4 * bj); bgg[bj] = *(const f32x4*)(bias + 512 + oc0 + 4 * bj); } }
        float ssr[2][4] = {{0.f, 0.f, 0.f, 0.f}, {0.f, 0.f, 0.f, 0.f}};
#pragma unroll
        for (int ai = 0; ai < 2; ++ai)
#pragma unroll
            for (int m = 0; m < 4; ++m) { float o[2][4];
#pragma unroll
                for (int bj = 0; bj < 2; ++bj) { const f32x4 a = acc[ai][bj][m][0], b = acc[ai][bj][m][1], bv = bvv[bj], bg = bgg[bj];
#pragma unroll
                    for (int i = 0; i < 4; ++i) { if (MODE == 0) o[bj][i] = (a[i] + bv[i]) * sigmoidf(b[i] + bg[i]); else o[bj][i] = a[i] * sigmoidf(a[i]) * b[i]; }
                    if (MODE == 0) ssr[ai][m] += o[bj][0] * o[bj][0] + o[bj][1] * o[bj][1] + o[bj][2] * o[bj][2] + o[bj][3] * o[bj][3]; }
                u32x4 w; w.x = pk2(o[0][0], o[0][1]); w.y = pk2(o[0][2], o[0][3]); w.z = pk2(o[1][0], o[1][1]); w.w = pk2(o[1][2], o[1][3]);
                *(u32x4*)(O + (size_t)(row0 + ai * HALF + m * 16) * ldo + oc0) = w; }
        if (MODE == 0) { int ln = fr + 16 * fq; asm volatile("" : "+v"(ln));
#pragma unroll
            for (int ai = 0; ai < 2; ++ai)
#pragma unroll
                for (int m = 0; m < 4; ++m) { float sq = ssr[ai][m]; sq += lane_get(sq, ln ^ 16); sq += lane_get(sq, ln ^ 32);
                    if (fq == 0) ssp[(size_t)(row0 + ai * HALF + m * 16) * 16 + u.pn * 4 + wc] = sq; } }
    }
    __device__ __forceinline__ void quarter(const f32x4 (&acc)[4][2], const Unit& u, int ha, int hb, int wr, int wc, int fr, int fq) const {
        const int row0 = u.pm * BM + ha * HALF + wr * 64 + fr, oc = u.pn * HALF + wc * 32 + 8 * fq + 4 * hb;
#pragma unroll
        for (int m = 0; m < 4; ++m) { const f32x4 a = acc[m][0], b = acc[m][1]; float o[4];
#pragma unroll
            for (int i = 0; i < 4; ++i) o[i] = a[i] * sigmoidf(a[i]) * b[i];
            u32x2 w; w.x = pk2(o[0], o[1]); w.y = pk2(o[2], o[3]);
            *(u32x2*)(O + (size_t)(row0 + m * 16) * ldo + oc) = w; }
    }
};
struct EpiResidBf16 {
    static constexpr bool PERM = true, MID = false, PRE = false;
    bf16_t* X;
    __device__ __forceinline__ void operator()(const f32x4 (&acc)[2][2][4][2], const Unit& u, int ui, int wr, int wc, int fr, int fq) const {
        const int row0 = u.pm * BM + wr * 64 + fr, col0 = u.pn * BM + wc * 32 + 8 * fq;
        u32x4 o[2][4][2];
#pragma unroll
        for (int ai = 0; ai < 2; ++ai)
#pragma unroll
            for (int m = 0; m < 4; ++m)
#pragma unroll
                for (int bj = 0; bj < 2; ++bj) o[ai][m][bj] = *(const u32x4*)(X + (size_t)(row0 + ai * HALF + m * 16) * D + col0 + bj * HALF);
#pragma unroll
        for (int ai = 0; ai < 2; ++ai)
#pragma unroll
            for (int m = 0; m < 4; ++m) { bf16_t* rowp = X + (size_t)(row0 + ai * HALF + m * 16) * D + col0;
#pragma unroll
                for (int bj = 0; bj < 2; ++bj) { const u32x4 ov = o[ai][m][bj]; const f32x4 v0 = acc[ai][bj][m][0], v1 = acc[ai][bj][m][1];
                    u32x4 w; w.x = pk2(ALPHA * bflo(ov.x) + v0[0], ALPHA * bfhi(ov.x) + v0[1]); w.y = pk2(ALPHA * bflo(ov.y) + v0[2], ALPHA * bfhi(ov.y) + v0[3]);
                    w.z = pk2(ALPHA * bflo(ov.z) + v1[0], ALPHA * bfhi(ov.z) + v1[1]); w.w = pk2(ALPHA * bflo(ov.w) + v1[2], ALPHA * bfhi(ov.w) + v1[3]);
                    *(u32x4*)(rowp + bj * HALF) = w; } }
    }
};
struct EpiResidRms {
    static constexpr bool PERM = true, MID = true, PRE = false;
    bf16_t* X; const PG8_LAS float* st;
    __device__ __forceinline__ void mid(f32x4 (&acc)[2][2][4][2], int ui, int wr, int fr) const {
#pragma unroll
        for (int ai = 0; ai < 2; ++ai)
#pragma unroll
            for (int m = 0; m < 4; ++m) { const float s = st[(ui * BM + ai * HALF + wr * 64 + m * 16 + fr) * 2];
#pragma unroll
                for (int bj = 0; bj < 2; ++bj)
#pragma unroll
                    for (int n = 0; n < 2; ++n) acc[ai][bj][m][n] *= s; }
    }
    __device__ __forceinline__ void operator()(const f32x4 (&acc)[2][2][4][2], const Unit& u, int ui, int wr, int wc, int fr, int fq) const {
        const int row0 = u.pm * BM + wr * 64 + fr, col0 = u.pn * BM + wc * 32 + 8 * fq;
        u32x4 o[2][4][2]; float sc[2][4];
#pragma unroll
        for (int ai = 0; ai < 2; ++ai)
#pragma unroll
            for (int m = 0; m < 4; ++m) { sc[ai][m] = st[(ui * BM + ai * HALF + wr * 64 + m * 16 + fr) * 2 + 1];
#pragma unroll
                for (int bj = 0; bj < 2; ++bj) o[ai][m][bj] = *(const u32x4*)(X + (size_t)(row0 + ai * HALF + m * 16) * D + col0 + bj * HALF); }
#pragma unroll
        for (int ai = 0; ai < 2; ++ai)
#pragma unroll
            for (int m = 0; m < 4; ++m) { bf16_t* rowp = X + (size_t)(row0 + ai * HALF + m * 16) * D + col0; const float s = sc[ai][m];
#pragma unroll
                for (int bj = 0; bj < 2; ++bj) { const u32x4 ov = o[ai][m][bj]; const f32x4 v0 = acc[ai][bj][m][0] * s, v1 = acc[ai][bj][m][1] * s;
                    u32x4 w; w.x = pk2(ALPHA * bflo(ov.x) + v0[0], ALPHA * bfhi(ov.x) + v0[1]); w.y = pk2(ALPHA * bflo(ov.y) + v0[2], ALPHA * bfhi(ov.y) + v0[3]);
                    w.z = pk2(ALPHA * bflo(ov.z) + v1[0], ALPHA * bfhi(ov.z) + v1[1]); w.w = pk2(ALPHA * bflo(ov.w) + v1[2], ALPHA * bfhi(ov.w) + v1[3]);
                    *(u32x4*)(rowp + bj * HALF) = w; } }
    }
};
struct EpiMoeOut {
    static constexpr bool PERM = true, MID = false, PRE = true;
    bf16_t* Y; const float* gate; const PG8_LAS unsigned* cn; PG8_LAS unsigned char* lb;
    __device__ __forceinline__ void unit_begin(const Unit& u, int ui, int wid, int lane) const {
        if (wid == 0) __builtin_amdgcn_global_load_lds((const unsigned*)(gate + (size_t)u.e * T + u.s0 + 4 * lane), (PG8_LAS unsigned*)(lb + (ui & 1) * 1024), 16, 0, 0);
    }
    __device__ __forceinline__ void operator()(const f32x4 (&acc)[2][2][4][2], const Unit& u, int ui, int wr, int wc, int fr, int fq) const {
        const int col0 = u.pn * BM + wc * 64 + 8 * fq;
        const unsigned n = cn[u.e];
        const PG8_LAS float* gl = (const PG8_LAS float*)(lb + (ui & 1) * 1024);
#pragma unroll
        for (int ai = 0; ai < 2; ++ai)
#pragma unroll
            for (int m = 0; m < 4; ++m) { const int sl = ai * HALF + wr * 64 + m * 16 + fr;
                if ((unsigned)(u.s0 + sl) < n) { bf16_t* rowp = Y + (size_t)(u.pm * BM + sl) * D + col0; const float g_ = gl[sl];
#pragma unroll
                    for (int bj = 0; bj < 2; ++bj) { const f32x4 v0 = acc[ai][bj][m][0] * g_, v1 = acc[ai][bj][m][1] * g_;
                        u32x4 w; w.x = pk2(v0[0], v0[1]); w.y = pk2(v0[2], v0[3]); w.z = pk2(v1[0], v1[1]); w.w = pk2(v1[2], v1[3]);
                        *(u32x4*)(rowp + bj * 32) = w; } } }
    }
    __device__ __forceinline__ void quarter(const f32x4 (&acc)[4][2], const Unit& u, int ha, int hb, int wr, int wc, int fr, int fq) const {
        const int col0 = u.pn * BM + wc * 64 + 8 * fq + 32 * hb; const unsigned n = cn[u.e];
        const PG8_LAS float* gl = (const PG8_LAS float*)lb;
#pragma unroll
        for (int m = 0; m < 4; ++m) { const int sl = ha * HALF + wr * 64 + m * 16 + fr;
            if ((unsigned)(u.s0 + sl) < n) { const float g_ = gl[sl]; const f32x4 v0 = acc[m][0] * g_, v1 = acc[m][1] * g_;
                u32x4 w; w.x = pk2(v0[0], v0[1]); w.y = pk2(v0[2], v0[3]); w.z = pk2(v1[0], v1[1]); w.w = pk2(v1[2], v1[3]);
                *(u32x4*)(Y + (size_t)(u.pm * BM + sl) * D + col0) = w; } }
    }
};

#ifndef PG8_ALIGN_EPI
#define PG8_ALIGN_EPI 1
#endif
template <class Epi, class Sched, bool GATHER>
__device__ __forceinline__ void gemm_phase(PG8_LAS unsigned char* lds, const Gemm g, const Sched& S, const Epi& E, int tid_in) {
    int tid_ = tid_in; asm volatile("" : "+v"(tid_));
    const int tid = tid_, wid = __builtin_amdgcn_readfirstlane(tid >> 6), lane = tid & 63, wr = wid >> 2, wc = wid & 3, fr = lane & 15, fq = lane >> 4;
    const int K = g.K, nt = K / BK;
    unsigned voffA[2], voffB[2]; int RA[2], CA[2];
#pragma unroll
    for (int i = 0; i < 2; ++i) { int R, C; stage_rc(tid * 16 + i * 8192, R, C); const int Rb = Epi::PERM ? ((R & ~31) + perm32(R & 31)) : R;
        voffA[i] = (unsigned)(R * K + C) * 2u; voffB[i] = (unsigned)(Rb * K + C) * 2u; RA[i] = R; CA[i] = C; }
    const size_t kstep = (size_t)(BK * 2);
    const size_t hstep = (size_t)HALF * K * 2;
    const size_t tstep = 2 * hstep;
    const unsigned ldsw = (unsigned)wid * 1024u;
    const int aoff = lds_byte(wr * 64 + fr, fq * 8), boff = lds_byte(wc * 32 + fr, fq * 8);
#define PG8_SA(b, h) (((b) * 2 + (h)) * HTB)
#define PG8_SB(b, h) ((4 + (b) * 2 + (h)) * HTB)
#define PG8_STAGE(bufoff, gbase, voff) do { _Pragma("unroll") for (int _i = 0; _i < 2; ++_i) \
        __builtin_amdgcn_global_load_lds((const unsigned*)((const char*)(gbase) + (voff)[_i]), (PG8_LAS unsigned*)(lds + (bufoff) + ldsw + _i * 8192), 16, 0, 0); } while (0)
#define PG8_STAGE_A(bufoff, abase, h, vg) do { if constexpr (GATHER) { PG8_STAGE(bufoff, abase, vg[h]); } else { PG8_STAGE(bufoff, (abase) + (h) * hstep, voffA); } } while (0)
#define PG8_LDA(dst, b, h) do { _Pragma("unroll") for (int m = 0; m < 4; ++m) _Pragma("unroll") for (int k = 0; k < 2; ++k) dst[m][k] = *(const PG8_LAS bf16x8*)(lds + PG8_SA(b, h) + aoff + m * 2048 + k * 1024); } while (0)
#define PG8_LDB(dst, b, h) do { _Pragma("unroll") for (int n = 0; n < 2; ++n) _Pragma("unroll") for (int k = 0; k < 2; ++k) dst[n][k] = *(const PG8_LAS bf16x8*)(lds + PG8_SB(b, h) + boff + n * 2048 + k * 1024); } while (0)
#define PG8_MMA(ai, bj, At, Bt) do { __builtin_amdgcn_s_setprio(1); _Pragma("unroll") for (int m = 0; m < 4; ++m) _Pragma("unroll") for (int n = 0; n < 2; ++n) _Pragma("unroll") for (int k = 0; k < 2; ++k) \
        acc[ai][bj][m][n] = __builtin_amdgcn_mfma_f32_16x16x32_bf16(Bt[n][k], At[m][k], acc[ai][bj][m][n], 0, 0, 0); __builtin_amdgcn_s_setprio(0); } while (0)
#define PG8_WAIT_V(n) asm volatile("s_waitcnt vmcnt(" #n ")" ::: "memory")
#define PG8_WAIT_L(n) asm volatile("s_waitcnt lgkmcnt(" #n ")" ::: "memory")
#define PG8_BAR __builtin_amdgcn_s_barrier()
#define PG8_SCHED __builtin_amdgcn_sched_barrier(0)
    Unit cur, nxt, nn; int ui = 0;
    if (!S.next(0, cur)) return;
    bool has_next = S.next(1, nxt);
    f32x4 acc[2][2][4][2];
#pragma unroll
    for (int a = 0; a < 2; ++a)
#pragma unroll
        for (int b = 0; b < 2; ++b)
#pragma unroll
            for (int m = 0; m < 4; ++m)
#pragma unroll
                for (int n = 0; n < 2; ++n) acc[a][b][m][n] = (f32x4){0.f, 0.f, 0.f, 0.f};
    bf16x8 At[4][2], B0[2][2], B1[2][2];
    unsigned vgC[2][2] = {{0u, 0u}, {0u, 0u}}, vgN[2][2] = {{0u, 0u}, {0u, 0u}};
    if constexpr (GATHER) {
#pragma unroll
        for (int h = 0; h < 2; ++h)
#pragma unroll
            for (int i = 0; i < 2; ++i) vgC[h][i] = S.a_off(cur, h, RA[i], CA[i]);
        if (has_next) S.stage_list(nxt, 1, wid, lane);
    }
    const char* cA = GATHER ? (const char*)g.A : (const char*)g.A + (size_t)cur.pm * tstep; const char* cB = (const char*)g.Bt + cur.bo;
    PG8_STAGE(PG8_SB(0, 0), cB, voffB); PG8_STAGE(PG8_SB(0, 1), cB + hstep, voffB); PG8_STAGE_A(PG8_SA(0, 0), cA, 0, vgC); PG8_STAGE_A(PG8_SA(0, 1), cA, 1, vgC);
    if (wr == 1) PG8_BAR;
    PG8_WAIT_V(2); PG8_BAR;
    PG8_STAGE(PG8_SB(1, 0), cB + kstep, voffB); PG8_STAGE_A(PG8_SA(1, 0), cA + kstep, 0, vgC); PG8_STAGE(PG8_SB(1, 1), cB + hstep + kstep, voffB);
    PG8_WAIT_V(6); PG8_BAR;
    for (;;) {
        if constexpr (Epi::PRE) E.unit_begin(cur, ui, wid, lane);
        const bool has2 = has_next && S.next(ui + 2, nn);
        const char* nA = GATHER ? (const char*)g.A : (has_next ? (const char*)g.A + (size_t)nxt.pm * tstep : cA); const char* nB = has_next ? (const char*)g.Bt + nxt.bo : cB;
        if constexpr (GATHER) {
#pragma unroll
            for (int h = 0; h < 2; ++h)
#pragma unroll
                for (int i = 0; i < 2; ++i) vgN[h][i] = has_next ? S.a_off_lds(nxt, (ui + 1) & 1, h, RA[i], CA[i]) : vgC[h][i];
            if (has2) S.stage_list(nn, ui & 1, wid, lane);
            asm volatile("" : "+v"(vgN[0][0]), "+v"(vgN[0][1]), "+v"(vgN[1][0]), "+v"(vgN[1][1]));
        }
        for (int hk = 0; hk < (Epi::MID ? 2 : 1); ++hk) {
        const int t0 = Epi::MID ? hk * (nt >> 1) : 0, t1 = Epi::MID ? (hk + 1) * (nt >> 1) : nt;
        for (int t = t0; t < t1; t += 2) {
            const bool last = (t == nt - 2);
            const char* a1 = cA + (size_t)(t + 1) * kstep;
            const char* a2 = last ? nA : cA + (size_t)(t + 2) * kstep; const char* b2 = last ? nB : cB + (size_t)(t + 2) * kstep;
            const char* a3 = a2 + kstep; const char* b3 = b2 + kstep;
            unsigned va2[2][2];
#pragma unroll
            for (int h = 0; h < 2; ++h)
#pragma unroll
                for (int i = 0; i < 2; ++i) va2[h][i] = last ? vgN[h][i] : vgC[h][i];
            PG8_LDB(B0, 0, 0); PG8_LDB(B1, 0, 1); PG8_SCHED; PG8_LDA(At, 0, 0); PG8_STAGE_A(PG8_SA(1, 1), a1, 1, vgC);
            PG8_WAIT_V(8); PG8_WAIT_L(0); PG8_BAR; PG8_MMA(0, 0, At, B0); PG8_MMA(0, 1, At, B1); PG8_BAR; PG8_SCHED;
            PG8_LDA(At, 0, 1); PG8_STAGE(PG8_SB(0, 0), b2, voffB); PG8_STAGE(PG8_SB(0, 1), b2 + hstep, voffB); PG8_STAGE_A(PG8_SA(0, 0), a2, 0, va2);
            PG8_WAIT_V(8); PG8_WAIT_L(0); PG8_BAR; PG8_MMA(1, 0, At, B0); PG8_MMA(1, 1, At, B1); PG8_BAR; PG8_SCHED;
            PG8_LDB(B0, 1, 0); PG8_LDB(B1, 1, 1); PG8_SCHED; PG8_LDA(At, 1, 0); PG8_STAGE_A(PG8_SA(0, 1), a2, 1, va2);
            PG8_WAIT_V(8); PG8_WAIT_L(0); PG8_BAR; PG8_MMA(0, 0, At, B0); PG8_MMA(0, 1, At, B1); PG8_BAR; PG8_SCHED;
            PG8_LDA(At, 1, 1); PG8_STAGE(PG8_SB(1, 0), b3, voffB); PG8_STAGE(PG8_SB(1, 1), b3 + hstep, voffB); PG8_STAGE_A(PG8_SA(1, 0), a3, 0, va2);
            PG8_WAIT_V(8); PG8_WAIT_L(0); PG8_BAR; PG8_MMA(1, 0, At, B0); PG8_MMA(1, 1, At, B1); PG8_BAR; PG8_SCHED;
        }
        if constexpr (Epi::MID) { if (hk == 0) { int l2 = lane; asm volatile("" : "+v"(l2)); E.mid(acc, ui, wr, l2 & 15); } }
        }
        if (PG8_ALIGN_EPI) { if (wr == 0) PG8_BAR; }
        PG8_WAIT_V(0);
        { int l2 = lane; asm volatile("" : "+v"(l2)); E(acc, cur, ui, wr, wc, l2 & 15, l2 >> 4); }
        if (!has_next) break;
#pragma unroll
        for (int a = 0; a < 2; ++a)
#pragma unroll
            for (int b = 0; b < 2; ++b)
#pragma unroll
                for (int m = 0; m < 4; ++m)
#pragma unroll
                    for (int n = 0; n < 2; ++n) acc[a][b][m][n] = (f32x4){0.f, 0.f, 0.f, 0.f};
        cur = nxt; nxt = nn; has_next = has2; cA = nA; cB = nB; ++ui;
        if constexpr (GATHER) {
#pragma unroll
            for (int h = 0; h < 2; ++h)
#pragma unroll
                for (int i = 0; i < 2; ++i) vgC[h][i] = vgN[h][i];
        }
        if (PG8_ALIGN_EPI) { if (wr == 1) PG8_BAR; }
    }
    PG8_WAIT_V(0);
    if (!PG8_ALIGN_EPI) { if (wr == 0) PG8_BAR; }
    PG8_BAR;
#undef PG8_SA
#undef PG8_SB
#undef PG8_STAGE
#undef PG8_STAGE_A
#undef PG8_LDA
#undef PG8_LDB
#undef PG8_MMA
#undef PG8_WAIT_V
#undef PG8_WAIT_L
#undef PG8_BAR
#undef PG8_SCHED
}

template <class Epi, class Sched, bool GATHER>
__device__ __forceinline__ void gemm_quarter(PG8_LAS unsigned char* lds, const Gemm g, const Sched& S, const Epi& E, int tid_in, const Unit& u, int ha, int hb) {
    int tid_ = tid_in; asm volatile("" : "+v"(tid_));
    const int tid = tid_, wid = __builtin_amdgcn_readfirstlane(tid >> 6), lane = tid & 63, wr = wid >> 2, wc = wid & 3, fr = lane & 15, fq = lane >> 4;
    const int K = g.K, nt = K / BK;
    unsigned voffA[2], voffB[2];
#pragma unroll
    for (int i = 0; i < 2; ++i) { int R, C; stage_rc(tid * 16 + i * 8192, R, C); const int Rb = (R & ~31) + perm32(R & 31);
        voffA[i] = GATHER ? S.a_off(u, ha, R, C) : (unsigned)(R * K + C) * 2u; voffB[i] = (unsigned)(Rb * K + C) * 2u; }
    const size_t kstep = (size_t)(BK * 2), hstep = (size_t)HALF * K * 2;
    const char* qA = GATHER ? (const char*)g.A : (const char*)g.A + (size_t)u.pm * 2 * hstep + (size_t)ha * hstep;
    const char* qB = (const char*)g.Bt + u.bo + (size_t)hb * hstep;
    const unsigned ldsw = (unsigned)wid * 1024u;
    const int aoff = lds_byte(wr * 64 + fr, fq * 8), boff = lds_byte(wc * 32 + fr, fq * 8);
#define PGQ_STAGE(st_, kt_) do { _Pragma("unroll") for (int _i = 0; _i < 2; ++_i) { \
        __builtin_amdgcn_global_load_lds((const unsigned*)(qA + (size_t)(kt_) * kstep + voffA[_i]), (PG8_LAS unsigned*)(lds + (st_) * 32768 + ldsw + _i * 8192), 16, 0, 0); \
        __builtin_amdgcn_global_load_lds((const unsigned*)(qB + (size_t)(kt_) * kstep + voffB[_i]), (PG8_LAS unsigned*)(lds + (st_) * 32768 + 16384 + ldsw + _i * 8192), 16, 0, 0); } } while (0)
    if constexpr (Epi::PRE) E.unit_begin(u, 0, wid, lane);
    PGQ_STAGE(0, 0); PGQ_STAGE(1, 1); PGQ_STAGE(2, 2);
    f32x4 acc[4][2];
#pragma unroll
    for (int m = 0; m < 4; ++m)
#pragma unroll
        for (int n = 0; n < 2; ++n) acc[m][n] = (f32x4){0.f, 0.f, 0.f, 0.f};
    for (int t = 0; t < nt; ++t) {
        asm volatile("s_waitcnt vmcnt(8)" ::: "memory");
        __builtin_amdgcn_s_barrier();
        { const int tn = (t + 3 < nt) ? t + 3 : nt - 1; PGQ_STAGE((t + 3) & 3, tn); }
        PG8_LAS unsigned char* sb = lds + (t & 3) * 32768;
        bf16x8 At[4][2], B0[2][2];
#pragma unroll
        for (int m = 0; m < 4; ++m)
#pragma unroll
            for (int k = 0; k < 2; ++k) At[m][k] = *(const PG8_LAS bf16x8*)(sb + aoff + m * 2048 + k * 1024);
#pragma unroll
        for (int n = 0; n < 2; ++n)
#pragma unroll
            for (int k = 0; k < 2; ++k) B0[n][k] = *(const PG8_LAS bf16x8*)(sb + 16384 + boff + n * 2048 + k * 1024);
#pragma unroll
        for (int m = 0; m < 4; ++m)
#pragma unroll
            for (int n = 0; n < 2; ++n)
#pragma unroll
                for (int k = 0; k < 2; ++k) acc[m][n] = __builtin_amdgcn_mfma_f32_16x16x32_bf16(B0[n][k], At[m][k], acc[m][n], 0, 0, 0);
    }
#undef PGQ_STAGE
    { int l2 = lane; asm volatile("" : "+v"(l2)); E.quarter(acc, u, ha, hb, wr, wc, l2 & 15, l2 >> 4); }
    asm volatile("s_waitcnt vmcnt(0)" ::: "memory");
    __builtin_amdgcn_s_barrier();
}
}

#define XB_TMO      128
#define XB_XCNT(j)  (256  + 64 * (j))
#define XB_XSUB(j)  (1280 + 64 * (j))
#define XB_XGEN(j)  (2304 + 64 * (j))
#define XB_TOP      3328
#define XB_TOPGEN   3392
#define XCD_BAR_WORDS 3456
#define XB_SPIN_CAP (1u << 18)
static_assert(XCD_BAR_WORDS == XCD_BAR_WORDS_C, "barrier words");
__device__ __forceinline__ unsigned xb_ld(unsigned* p)              { return __hip_atomic_load(p, __ATOMIC_RELAXED, __HIP_MEMORY_SCOPE_AGENT); }
__device__ __forceinline__ unsigned xb_add(unsigned* p, unsigned v) { return __hip_atomic_fetch_add(p, v, __ATOMIC_RELAXED, __HIP_MEMORY_SCOPE_AGENT); }
__device__ __forceinline__ unsigned xb_xcc_id() { return (unsigned)__builtin_amdgcn_s_getreg((3 << 11) | 20) & 0xFu; }
#define XB_SPIN(cond, bar) do { unsigned _sp = 0; while (cond) { __builtin_amdgcn_s_sleep(1); \
    if ((++_sp & 255u) == 0u) { if (xb_ld(&(bar)[XB_TMO])) break; if (_sp > XB_SPIN_CAP) { atomicAdd(&(bar)[XB_TMO], 1u); break; } } } } while (0)
struct XcdBarrier { unsigned* bar; unsigned x; volatile LAS unsigned* st; };
__device__ __forceinline__ XcdBarrier xcd_barrier_post(unsigned* bar, volatile LAS unsigned* st) {
    XcdBarrier b; b.bar = bar; b.x = xb_xcc_id(); b.st = st;
    if (threadIdx.x == 0) (void)xb_add(&bar[XB_XCNT(b.x)], 1u);
    return b;
}
__device__ __forceinline__ void xcd_barrier_complete(unsigned* bar, unsigned x, unsigned& nloc, unsigned& nx) {
    const unsigned G = gridDim.x * gridDim.y * gridDim.z;
    unsigned sum, cnt, mine, sp = 0u;
    for (;;) {
        sum = 0u; cnt = 0u; mine = 0u;
#pragma unroll
        for (unsigned j = 0; j < 16; ++j) { const unsigned c = xb_ld(&bar[XB_XCNT(j)]); sum += c; cnt += (c > 0u) ? 1u : 0u; mine = (j == x) ? c : mine; }
        if (sum == G) break;
        __builtin_amdgcn_s_sleep(1);
        if ((++sp & 255u) == 0u) { if (xb_ld(&bar[XB_TMO])) break; if (sp > XB_SPIN_CAP) { atomicAdd(&bar[XB_TMO], 1u); break; } }
    }
    nloc = mine > 0u ? mine : 1u; nx = cnt > 0u ? cnt : 1u;
}
__device__ __forceinline__ void xcd_barrier(const XcdBarrier& b, int tid) {
    asm volatile("s_waitcnt vmcnt(0)" ::: "memory");
    __syncthreads();
    if (tid == 0) {
        __attribute__((address_space(1))) unsigned* barg = (__attribute__((address_space(1))) unsigned*)b.bar; unsigned bx_ = b.x; asm volatile("" : "+s"(barg), "+s"(bx_)); unsigned* bar = (unsigned*)barg;
        __builtin_amdgcn_s_waitcnt(0);
        unsigned nloc = b.st[0], nx = b.st[1]; const unsigned nb = b.st[2]; b.st[2] = nb + 1u;
        if (nloc == 0u) { xcd_barrier_complete(bar, bx_, nloc, nx); b.st[0] = nloc; b.st[1] = nx; }
        const unsigned old = xb_add(&bar[XB_XSUB(bx_)], 1u);
        const unsigned gen = old / nloc;
        if (old + 1u == (gen + 1u) * nloc) {
            __builtin_amdgcn_fence(__ATOMIC_RELEASE, "agent");
            asm volatile("s_waitcnt vmcnt(0)" ::: "memory");
            const unsigned og = xb_add(&bar[XB_TOP], 1u);
            const unsigned tg = og / nx;
            if (og + 1u == (tg + 1u) * nx) xb_add(&bar[XB_TOPGEN], 1u);
            else XB_SPIN(xb_ld(&bar[XB_TOPGEN]) == tg, bar);
            __builtin_amdgcn_fence(__ATOMIC_ACQUIRE, "agent");
            asm volatile("s_waitcnt vmcnt(0)" ::: "memory");
        } else {
            XB_SPIN(xb_ld(&bar[XB_TOPGEN]) == nb, bar);
            __builtin_amdgcn_fence(__ATOMIC_ACQUIRE, "agent");
            asm volatile("s_waitcnt vmcnt(0)" ::: "memory");
        }
    }
    __syncthreads();
}

struct Args { const float* in[33]; float* out; unsigned char* ws; int ph_lo, ph_hi, li, pad; };
typedef float f32x4 __attribute__((ext_vector_type(4)));
typedef unsigned u32x4 __attribute__((ext_vector_type(4)));
typedef unsigned u32x2 __attribute__((ext_vector_type(2)));
typedef short bf16x8 __attribute__((ext_vector_type(8)));
#define LDS_WAIT() asm volatile("s_waitcnt lgkmcnt(0)" ::: "memory")
template <class TT> __device__ __forceinline__ TT ldg(const void* ubase, unsigned off) { return *(const TT*)((const char*)ubase + off); }
template <class TT> __device__ __forceinline__ void stg(void* ubase, unsigned off, TT v) { *(TT*)((char*)ubase + off) = v; }
#define CBAR() asm volatile("" ::: "memory")

constexpr int TRJ0 = 16 * 48, TRJ1 = TRJ0 + 8 * 32, TRJ2 = TRJ1 + 16 * 32, TRJ3 = TRJ2 + NE * 256, TRJ4 = TRJ3 + NE * 256, TRJ = TRJ4 + NE * 256;
#define TR_DECODE(L_, it_, W_, WT_, K_, N_, IL_, OFF_, K0_, N0_) do { const int it__ = (it_); \
    if (it__ < TRJ0) { const int q = it__; W_ = a.in[1] + (size_t)(L_) * D * NPROJ; WT_ = WinT + (size_t)(L_) * NPROJ * D; K_ = D; N_ = NPROJ; IL_ = 0; OFF_ = 0; K0_ = (q / 48) * 64; N0_ = (q % 48) * 32; } \
    else if (it__ < TRJ1) { const int q = it__ - TRJ0; W_ = a.in[17] + (size_t)(L_) * 512 * 1024; WT_ = WgluT + (size_t)(L_) * 1024 * 512; K_ = 512; N_ = 1024; IL_ = 1; OFF_ = 0; K0_ = (q / 32) * 64; N0_ = (q % 32) * 32; } \
    else if (it__ < TRJ2) { const int q = it__ - TRJ1; W_ = a.in[21] + (size_t)(L_) * 1024 * 1024; WT_ = WoutT + (size_t)(L_) * 1024 * 1024; K_ = 1024; N_ = 1024; IL_ = 0; OFF_ = 0; K0_ = (q / 32) * 64; N0_ = (q % 32) * 32; } \
    else if (it__ < TRJ3) { const int r = it__ - TRJ2, bt = (L_) * NE + (r >> 8), q = r & 255; W_ = a.in[28] + (size_t)bt * 1024 * 512; WT_ = WguT + (size_t)bt * 1024 * 1024; K_ = 1024; N_ = 512; IL_ = 1; OFF_ = 0; K0_ = (q / 16) * 64; N0_ = (q % 16) * 32; } \
    else if (it__ < TRJ4) { const int r = it__ - TRJ3, bt = (L_) * NE + (r >> 8), q = r & 255; W_ = a.in[29] + (size_t)bt * 1024 * 512; WT_ = WguT + (size_t)bt * 1024 * 1024; K_ = 1024; N_ = 512; IL_ = 1; OFF_ = 4; K0_ = (q / 16) * 64; N0_ = (q % 16) * 32; } \
    else { const int r = it__ - TRJ4, bt = (L_) * NE + (r >> 8), q = r & 255; W_ = a.in[30] + (size_t)bt * 512 * 1024; WT_ = WdT + (size_t)bt * 1024 * 512; K_ = 512; N_ = 1024; IL_ = 2; OFF_ = 0; K0_ = (q / 32) * 64; N0_ = (q % 32) * 32; } } while (0)
#define TR_DMA(scr_, W_, N_, K0_, N0_) do { _Pragma("unroll") for (int i_ = 0; i_ < 8; ++i_) \
    __builtin_amdgcn_global_load_lds((const unsigned*)((W_) + (size_t)((K0_) + 8 * i_ + (lane >> 3)) * (N_) + (N0_) + 4 * ((lane & 7) ^ i_)), (LAS unsigned*)((LAS unsigned char*)(scr_) + i_ * 1024), 16, 0, 2); } while (0)
#define TR_OUT(scr_, WT_, K_, IL_, OFF_, K0_, N0_) do { const int c8_ = lane & 7; \
    _Pragma("unroll") for (int j_ = 0; j_ < 4; ++j_) { const int nl_ = (lane >> 3) + 8 * j_, n_ = (N0_) + nl_; const LAS float* s_ = (scr_) + (8 * c8_) * 32 + (nl_ ^ (4 * c8_)); \
        u32x4 o_; o_.x = pk2(s_[0], s_[32]); o_.y = pk2(s_[64], s_[96]); o_.z = pk2(s_[128], s_[160]); o_.w = pk2(s_[192], s_[224]); \
        const int oc_ = n_ & 511; const int r_ = ((IL_) == 1) ? (256 * (oc_ >> 7) + 128 * ((oc_ >> 2) & 1) + 32 * ((oc_ >> 5) & 3) + 8 * ((oc_ >> 3) & 3) + (oc_ & 3) + 4 * (n_ >> 9) + (OFF_)) : ((IL_) == 2) ? ((n_ & ~255) + 128 * ((n_ >> 5) & 1) + 32 * ((n_ >> 6) & 3) + (n_ & 31)) : n_; \
        __builtin_nontemporal_store(o_, (u32x4*)((WT_) + (size_t)r_ * (K_) + (K0_) + 8 * c8_)); } \
    CBAR(); } while (0)
#define TR_STORE(v_, scr_, WT_, K_, IL_, OFF_, K0_, N0_) do { \
    _Pragma("unroll") for (int i_ = 0; i_ < 8; ++i_) { const int k_ = 8 * i_ + (lane >> 3), c_ = 4 * (lane & 7); *(LAS f32x4*)((scr_) + k_ * 32 + (c_ ^ (4 * ((k_ >> 3) & 7)))) = v_[i_]; } \
    { const int c8_ = lane & 7; \
    _Pragma("unroll") for (int j_ = 0; j_ < 4; ++j_) { const int nl_ = (lane >> 3) + 8 * j_, n_ = (N0_) + nl_; const LAS float* s_ = (scr_) + (8 * c8_) * 32 + (nl_ ^ (4 * c8_)); \
        u32x4 o_; o_.x = pk2(s_[0], s_[32]); o_.y = pk2(s_[64], s_[96]); o_.z = pk2(s_[128], s_[160]); o_.w = pk2(s_[192], s_[224]); \
        const int oc_ = n_ & 511; const int r_ = ((IL_) == 1) ? (256 * (oc_ >> 7) + 128 * ((oc_ >> 2) & 1) + 32 * ((oc_ >> 5) & 3) + 8 * ((oc_ >> 3) & 3) + (oc_ & 3) + 4 * (n_ >> 9) + (OFF_)) : ((IL_) == 2) ? ((n_ & ~255) + 128 * ((n_ >> 5) & 1) + 32 * ((n_ >> 6) & 3) + (n_ & 31)) : n_; \
        *(u32x4*)((WT_) + (size_t)r_ * (K_) + (K0_) + 8 * c8_) = o_; } } \
    CBAR(); } while (0)
#define TR_LOAD(v_, W_, N_, K0_, N0_) do { const unsigned vo_ = (unsigned)((lane >> 3) * (N_) + 4 * (lane & 7)) * 4u; _Pragma("unroll") for (int i_ = 0; i_ < 8; ++i_) v_[i_] = ldg<f32x4>((W_) + (size_t)((K0_) + 8 * i_) * (N_) + (N0_), vo_); } while (0)
__global__ void __launch_bounds__(NTHREADS, 2) mk_fwd(Args a) {
    extern __shared__ __attribute__((aligned(16))) unsigned char lds_raw[];
    LAS unsigned char* lds = (LAS unsigned char*)lds_raw;
    const int tid = threadIdx.x, wave0 = __builtin_amdgcn_readfirstlane(tid >> 6);
    const int G0 = gridDim.x, bx0 = blockIdx.x;
    unsigned char* ws = a.ws; unsigned* ctl = (unsigned*)(ws + WS_CTL); float* xf = a.out;
    volatile LAS unsigned* lc_bar = (volatile LAS unsigned*)(lds + LDS_CTL + LC_BAR);
    for (int u = tid; u < LDS_RING / 4; u += NTHREADS) ((LAS unsigned*)(lds + LDS_CTL))[u] = 0u;
    __syncthreads();
    XcdBarrier bar = xcd_barrier_post(ctl + CW_BAR + a.li * XCD_BAR_WORDS, lc_bar);

    if (a.ph_lo == 0) {
        const int ph = 0;
        int G_ = G0, bx_ = bx0, wave_ = wave0; asm volatile("" : "+s"(G_), "+s"(bx_), "+s"(wave_));
        const int G = G_, bx = bx_, wave = wave_, vcu = (G % 8 == 0) ? (bx % 8) * (G / 8) + bx / 8 : bx, gw = vcu * NWAVES + wave, NGW = G * NWAVES;
        int tid; asm volatile("v_mbcnt_lo_u32_b32 %0, -1, 0\n\tv_mbcnt_hi_u32_b32 %0, -1, %0\n\tv_add_u32 %0, %1, %0" : "=v"(tid) : "s"(wave * 64));
        const int lane = tid & 63;
        const char __attribute__((address_space(4)))* kp_ = (const char __attribute__((address_space(4)))*)__builtin_amdgcn_kernarg_segment_ptr(); asm volatile("" : "+s"(kp_));
        const float* const __attribute__((address_space(4)))* in_ = (const float* const __attribute__((address_space(4)))*)kp_;
        LAS unsigned char* ldp = lds; asm volatile("" : "+s"(ldp));
        LAS unsigned char* ring = ldp + LDS_RING;
        LAS int* lc_tb = (LAS int*)(ldp + LDS_CTL + LC_TB); LAS unsigned* lc_cn = (LAS unsigned*)(ldp + LDS_CTL + LC_CN);
        LAS unsigned* lc_lcnt = (LAS unsigned*)(ldp + LDS_CTL + LC_LCNT); LAS unsigned* lc_gb = (LAS unsigned*)(ldp + LDS_CTL + LC_GB);
        LAS int* lc_ent = (LAS int*)(ldp + LDS_CTL + LC_ENT); LAS unsigned* lc_rank = (LAS unsigned*)(ldp + LDS_CTL + LC_RANK); LAS float* lc_gv = (LAS float*)(ldp + LDS_CTL + LC_GV);
        __attribute__((address_space(1))) unsigned char* wsg = (__attribute__((address_space(1))) unsigned char*)ws; asm volatile("" : "+s"(wsg)); unsigned char* wsp = (unsigned char*)wsg;
        bf16 *WinT = (bf16*)(wsp + WS_WIN), *WgluT = (bf16*)(wsp + WS_WGLU), *WoutT = (bf16*)(wsp + WS_WOUT), *WguT = (bf16*)(wsp + WS_WGU), *WdT = (bf16*)(wsp + WS_WD), *WrT = (bf16*)(wsp + WS_WRT);
        float* a16t = (float*)(wsp + WS_A16); float* rcst = (float*)(wsp + WS_RC);
        bf16 *B16 = (bf16*)(wsp + WS_B16), *WS5 = (bf16*)(wsp + WS_WS5), *WgT = (bf16*)(wsp + WS_WGT); float* gbias = (float*)(wsp + WS_GB);
        bf16 *xb = (bf16*)(wsp + WS_XB), *proj = (bf16*)(wsp + WS_PROJ), *ys = (bf16*)(wsp + WS_YS), *yrec = (bf16*)(wsp + WS_YREC), *ug = (bf16*)(wsp + WS_UG), *ycat = (bf16*)(wsp + WS_YCAT);
        bf16 *Hb = (bf16*)(wsp + WS_H), *Yb = (bf16*)(wsp + WS_Y);
        float *ss1p = (float*)(wsp + WS_YREC), *ss2p = (float*)(wsp + WS_UG);
        float* gate = (float*)(wsp + WS_GATE); int* list = (int*)(wsp + WS_LIST); int* inv = (int*)(wsp + WS_EID);
        {
            LAS float* scr = (LAS float*)(ring + wave * 16384);
            const int gwl = vcu * NWAVES + __builtin_amdgcn_readfirstlane(tid >> 6);
            const int TRN = (NGW == 2048) ? TRJ0 : DEPTH * TRJ;
            if (gwl < TRN) {
                const float* cW; bf16* cWT; int cK, cN, cIL, cOFF, cK0, cN0; f32x4 v[8];
                TR_DECODE(gwl / TRJ, gwl % TRJ, cW, cWT, cK, cN, cIL, cOFF, cK0, cN0); TR_LOAD(v, cW, cN, cK0, cN0);
                for (int it = gwl;;) {
                    const float* nW; bf16* nWT; int nK, nN, nIL, nOFF, nK0, nN0; f32x4 vn[8];
                    const int itn = it + NGW; const bool more = itn < TRN; const int itd = more ? itn : it;
                    TR_DECODE(itd / TRJ, itd % TRJ, nW, nWT, nK, nN, nIL, nOFF, nK0, nN0); TR_LOAD(vn, nW, nN, nK0, nN0);
                    { const int cj = it % TRJ; if (!(cj >= TRJ1 && cj < TRJ2)) TR_STORE(v, scr, cWT, cK, cIL, cOFF, cK0, cN0); }
                    if (!more) break;
#pragma unroll
                    for (int i = 0; i < 8; ++i) v[i] = vn[i];
                    cW = nW; cWT = nWT; cK = nK; cN = nN; cIL = nIL; cOFF = nOFF; cK0 = nK0; cN0 = nN0; it = itn;
                }
            }
            { const int c8 = lane & 7;
              for (int j = gwl; j < DEPTH * 512; j += NGW) {
                const int wl = j >> 9, K0 = ((j & 511) >> 5) * 64, N0 = (j & 31) * 32;
                const float* W = in_[21] + (size_t)wl * 1024 * 1024; bf16* WT = WoutT + (size_t)wl * 1024 * 1024;
                f32x4 v[8]; TR_LOAD(v, W, 1024, K0, N0);
                const float* gp = (K0 < 512) ? in_[19] + wl * 512 + K0 : in_[20] + wl * 512 + (K0 - 512);
                const f32x4 g0 = *(const f32x4*)(gp + 8 * c8), g1 = *(const f32x4*)(gp + 8 * c8 + 4);
#pragma unroll
                for (int i_ = 0; i_ < 8; ++i_) { const int k_ = 8 * i_ + (lane >> 3), c_ = 4 * (lane & 7); *(LAS f32x4*)(scr + k_ * 32 + (c_ ^ (4 * ((k_ >> 3) & 7)))) = v[i_]; }
#pragma unroll
                for (int j_ = 0; j_ < 4; ++j_) { const int nl_ = (lane >> 3) + 8 * j_, n_ = N0 + nl_; const LAS float* s_ = scr + (8 * c8) * 32 + (nl_ ^ (4 * c8));
                    u32x4 o_; o_.x = pk2(s_[0] * g0[0], s_[32] * g0[1]); o_.y = pk2(s_[64] * g0[2], s_[96] * g0[3]); o_.z = pk2(s_[128] * g1[0], s_[160] * g1[1]); o_.w = pk2(s_[192] * g1[2], s_[224] * g1[3]);
                    *(u32x4*)(WT + (size_t)n_ * 1024 + K0 + 8 * c8) = o_; }
                CBAR(); } }
            const int gt = vcu * NTHREADS + tid, NGT = G * NTHREADS;
            for (int idx = gt; idx < DEPTH * 48 * D; idx += NGT) { const int l = idx / (48 * D), n = (idx / D) % 48, k = idx % D;
                const float v = n < 32 ? in_[26][((size_t)l * D + k) * NE + n] : (n < 36 ? in_[24][((size_t)l * D + k) * NEG + (n - 32)] : 0.f);
                WrT[(size_t)l * 48 * D + ((((n >> 4) * 32 + (k >> 5)) * 64) + (n & 15) + 16 * ((k >> 3) & 3)) * 8 + (k & 7)] = f2bf(v * in_[22][l * D + k]); }
            for (int idx = gw; idx < DEPTH * 48; idx += NGW) { const int l = idx / 48, n = idx % 48; float c1 = 0.f, c0 = 0.f;
                float wv[16], gv[16], bv[16];
#pragma unroll
                for (int i = 0; i < 16; ++i) { const int k = lane + 64 * i; wv[i] = n < 32 ? in_[26][((size_t)l * D + k) * NE + n] : (n < 36 ? in_[24][((size_t)l * D + k) * NEG + (n - 32)] : 0.f);
                    gv[i] = in_[22][l * D + k]; bv[i] = in_[23][l * D + k]; }
#pragma unroll
                for (int i = 0; i < 16; ++i) { c1 += bf2f(f2bf(wv[i] * gv[i])); c0 += wv[i] * bv[i]; }
                c1 = wave_sum(c1, lane); c0 = wave_sum(c0, lane);
                c0 += n < 32 ? in_[27][l * NE + n] : (n < 36 ? in_[25][l * NEG + (n - 32)] : 0.f);
                if (lane == 0) { rcst[(l * 2 + 0) * 48 + n] = c1; rcst[(l * 2 + 1) * 48 + n] = c0; } }
            for (int idx0 = gt; idx0 < DEPTH * NGRP * 2 * GC * 256; idx0 += NGT * 8) {
                float wv[8], mv[8];
#pragma unroll
                for (int j = 0; j < 8; ++j) { const int idx = idx0 + j * NGT;
                    if (idx < DEPTH * NGRP * 2 * GC * 256) { const int lg = idx >> 13, gsel = (idx >> 12) & 1, c = (idx >> 8) & 15, kk = idx & 255, tap = kk >> 6, i = kk & 63, l = lg / NGRP, g = lg % NGRP, hh = g >> 2, jh = GC * (g & 3) + c;
                        wv[j] = in_[2][((size_t)l * 4 + tap) * DREC + HD * hh + i]; mv[j] = in_[gsel ? 6 : 4][(((size_t)l * NH + hh) * HD + i) * HD + jh]; } else { wv[j] = 0.f; mv[j] = 0.f; } }
#pragma unroll
                for (int j = 0; j < 8; ++j) { const int idx = idx0 + j * NGT; if (idx < DEPTH * NGRP * 2 * GC * 256) { const int c = (idx >> 8) & 15, kk = idx & 255;
                        WgT[(idx & ~4095) + (((kk >> 5) * 64) + c + 16 * ((kk >> 3) & 3)) * 8 + (kk & 7)] = f2bf(-1.4426950408889634f * (wv[j] * mv[j])); } } }
            for (int idx = gw; idx < DEPTH * NGRP * 2 * GC; idx += NGW) {
                const int lg = idx >> 5, gsel = (idx >> 4) & 1, c = idx & 15, l = lg / NGRP, g = lg % NGRP, hh = g >> 2, jh = GC * (g & 3) + c;
                float s = in_[3][l * DREC + HD * hh + lane] * in_[gsel ? 6 : 4][(((size_t)l * NH + hh) * HD + lane) * HD + jh];
                s = wave_sum(s, lane);
                if (lane == 0) gbias[idx] = -1.4426950408889634f * (s + in_[gsel ? 7 : 5][l * DREC + HD * hh + jh]); }
            {
                LAS float* pwr = (LAS float*)ring; LAS float* pwi = pwr + 64 * 17; LAS float* bbr = pwi + 64 * 17; LAS float* bbi = bbr + 1024;
                LAS float* cmr = bbi + 1024; LAS float* cmi = cmr + 1024; LAS float* ktl = cmi + 1024;
                for (int lg = vcu; lg < DEPTH * NGRP; lg += G) {
                    __syncthreads();
                    if (tid < NST) { const int sn = lg * NST + tid;
                        const float lre = fminf(in_[9][sn], -1e-4f), lim = in_[10][sn], dt = expf(in_[11][lg]);
                        const float mag = expf(lre * dt), ar = mag * cosf(lim * dt), ai = mag * sinf(lim * dt);
                        const float den = lre * lre + lim * lim, pr0 = ar - 1.f, pi0 = ai;
                        const float cr = (pr0 * lre + pi0 * lim) / den, ci = (pi0 * lre - pr0 * lim) / den;
                        float pr = 1.f, pi = 0.f;
                        for (int tau = 0; tau <= 16; ++tau) { pwr[tid * 17 + tau] = pr; pwi[tid * 17 + tau] = pi; const float nr = pr * ar - pi * ai, ni = pr * ai + pi * ar; pr = nr; pi = ni; }
                        a16t[sn * 2] = pwr[tid * 17 + 16]; a16t[sn * 2 + 1] = pwi[tid * 17 + 16];
                        f32x4 brv[4], biv[4];
#pragma unroll
                        for (int c4 = 0; c4 < 4; ++c4) { brv[c4] = *(const f32x4*)(in_[12] + (size_t)sn * GC + 4 * c4); biv[c4] = *(const f32x4*)(in_[13] + (size_t)sn * GC + 4 * c4); }
#pragma unroll
                        for (int c = 0; c < GC; ++c) { const float br = brv[c >> 2][c & 3], bi = biv[c >> 2][c & 3];
                            bbr[tid * GC + c] = cr * br - ci * bi; bbi[tid * GC + c] = cr * bi + ci * br; } }
                    for (int i = tid; i < GC * NST; i += NTHREADS) { cmr[i] = in_[14][(size_t)lg * GC * NST + i]; cmi[i] = in_[15][(size_t)lg * GC * NST + i]; }
                    __syncthreads();
                    for (int i = tid; i < 4096; i += NTHREADS) { const int tau = i >> 8, co = (i >> 4) & 15, ci = i & 15; float s = 0.f;
                        for (int n = 0; n < NST; ++n) { const float c_r = cmr[co * NST + n], c_i = cmi[co * NST + n], p_r = pwr[n * 17 + tau], p_i = pwi[n * 17 + tau];
                            const float mr = c_r * p_r - c_i * p_i, mi = c_r * p_i + c_i * p_r; s += mr * bbr[n * GC + ci] - mi * bbi[n * GC + ci]; }
                        if (tau == 0 && co == ci) s += in_[16][lg * GC + co];
                        ktl[i] = s; }
                    __syncthreads();
                    for (int i = tid; i < 256 * 384; i += NTHREADS) { const int e_ = i & 7, ln = (i >> 3) & 63, fk = i >> 9, nt_ = fk / 12, ks_ = fk - nt_ * 12;
                        const int n = 16 * nt_ + (ln & 15), kk = (ks_ < 4 ? 256 + 32 * ks_ : 32 * (ks_ - 4)) + 8 * (ln >> 4) + e_, tp = n >> 4, co = n & 15; float v;
                        if (kk < 256) { const int sp = kk >> 4, ci = kk & 15; v = (sp <= tp) ? ktl[((tp - sp) * 16 + co) * 16 + ci] : 0.f; }
                        else { const int nn = (kk - 256) >> 1; const float c_r = cmr[co * NST + nn], c_i = cmi[co * NST + nn], p_r = pwr[nn * 17 + tp + 1], p_i = pwi[nn * 17 + tp + 1];
                            const float mr = c_r * p_r - c_i * p_i, mi = c_r * p_i + c_i * p_r; v = (kk & 1) ? -mi : mr; }
                        WS5[(size_t)lg * 256 * 384 + i] = f2bf(v); }
                    for (int i = tid; i < 128 * 256; i += NTHREADS) { const int e_ = i & 7, ln = (i >> 3) & 63, fk = i >> 9, nt_ = fk >> 3, ks_ = fk & 7;
                        const int np = 16 * nt_ + (ln & 15), kk = 32 * ks_ + 8 * (ln >> 4) + e_, tp = kk >> 4, c = kk & 15, n = np & 63;
                        const float p_r = pwr[n * 17 + 15 - tp], p_i = pwi[n * 17 + 15 - tp], br = bbr[n * GC + c], bi = bbi[n * GC + c];
                        B16[(size_t)lg * 128 * 256 + i] = f2bf(np < 64 ? (p_r * br - p_i * bi) : (p_r * bi + p_i * br)); }
                }
                __syncthreads();
            }
            { const f32x4* xs = (const f32x4*)in_[0]; u32x2* xd = (u32x2*)xb; const size_t n4 = (size_t)T * D / 4;
              const bool split = (G == 256); const int xg = split ? (vcu - 128) * NTHREADS + tid : gt, XN = split ? 128 * NTHREADS : NGT;
              if (!split || vcu >= 128)
              for (size_t i = (size_t)xg; i < n4; i += (size_t)XN * 8) { f32x4 v[8];
#pragma unroll
                for (int j = 0; j < 8; ++j) { const size_t ii = i + (size_t)j * XN; v[j] = ii < n4 ? xs[ii] : (f32x4){0.f, 0.f, 0.f, 0.f}; }
#pragma unroll
                for (int j = 0; j < 8; ++j) { const size_t ii = i + (size_t)j * XN; if (ii < n4) { u32x2 w; w.x = pk2(v[j][0], v[j][1]); w.y = pk2(v[j][2], v[j][3]); xd[ii] = w; } } } }
        }
        if (1 < a.ph_hi) xcd_barrier(bar, tid);
    }
    for (int ph = (a.ph_lo < 1 ? 1 : a.ph_lo); ph < a.ph_hi; ++ph) {
      const int kind = (ph - 1) % 10; const int reps = ((a.pad >> kind) & 1) ? 2 : 1;
      for (int rep = 0; rep < reps; ++rep) {
        int G_ = G0, bx_ = bx0, wave_ = wave0; asm volatile("" : "+s"(G_), "+s"(bx_), "+s"(wave_));
        const int G = G_, bx = bx_, wave = wave_, vcu = (G % 8 == 0) ? (bx % 8) * (G / 8) + bx / 8 : bx, gw = vcu * NWAVES + wave, NGW = G * NWAVES;
        int tid; asm volatile("v_mbcnt_lo_u32_b32 %0, -1, 0\n\tv_mbcnt_hi_u32_b32 %0, -1, %0\n\tv_add_u32 %0, %1, %0" : "=v"(tid) : "s"(wave * 64));
        const int lane = tid & 63;
        const char __attribute__((address_space(4)))* kp_ = (const char __attribute__((address_space(4)))*)__builtin_amdgcn_kernarg_segment_ptr(); asm volatile("" : "+s"(kp_));
        const float* const __attribute__((address_space(4)))* in_ = (const float* const __attribute__((address_space(4)))*)kp_;
        LAS unsigned char* ldp = lds; asm volatile("" : "+s"(ldp));
        LAS unsigned char* ring = ldp + LDS_RING;
        LAS int* lc_tb = (LAS int*)(ldp + LDS_CTL + LC_TB); LAS unsigned* lc_cn = (LAS unsigned*)(ldp + LDS_CTL + LC_CN);
        LAS unsigned* lc_lcnt = (LAS unsigned*)(ldp + LDS_CTL + LC_LCNT); LAS unsigned* lc_gb = (LAS unsigned*)(ldp + LDS_CTL + LC_GB);
        LAS int* lc_ent = (LAS int*)(ldp + LDS_CTL + LC_ENT); LAS unsigned* lc_rank = (LAS unsigned*)(ldp + LDS_CTL + LC_RANK); LAS float* lc_gv = (LAS float*)(ldp + LDS_CTL + LC_GV);
        __attribute__((address_space(1))) unsigned char* wsg = (__attribute__((address_space(1))) unsigned char*)ws; asm volatile("" : "+s"(wsg)); unsigned char* wsp = (unsigned char*)wsg;
        bf16 *WinT = (bf16*)(wsp + WS_WIN), *WgluT = (bf16*)(wsp + WS_WGLU), *WoutT = (bf16*)(wsp + WS_WOUT), *WguT = (bf16*)(wsp + WS_WGU), *WdT = (bf16*)(wsp + WS_WD), *WrT = (bf16*)(wsp + WS_WRT);
        float* a16t = (float*)(wsp + WS_A16); float* rcst = (float*)(wsp + WS_RC);
        bf16 *B16 = (bf16*)(wsp + WS_B16), *WS5 = (bf16*)(wsp + WS_WS5), *WgT = (bf16*)(wsp + WS_WGT); float* gbias = (float*)(wsp + WS_GB);
        bf16 *xb = (bf16*)(wsp + WS_XB), *proj = (bf16*)(wsp + WS_PROJ), *ys = (bf16*)(wsp + WS_YS), *yrec = (bf16*)(wsp + WS_YREC), *ug = (bf16*)(wsp + WS_UG), *ycat = (bf16*)(wsp + WS_YCAT);
        bf16 *Hb = (bf16*)(wsp + WS_H), *Yb = (bf16*)(wsp + WS_Y);
        float *ss1p = (float*)(wsp + WS_YREC), *ss2p = (float*)(wsp + WS_UG);
        float* gate = (float*)(wsp + WS_GATE); int* list = (int*)(wsp + WS_LIST); int* inv = (int*)(wsp + WS_EID);
        {
            const int l = (ph - 1) / 10, k = (ph - 1) % 10;
            if (k == 0) {
                pg8::Gemm g{xb, WinT + (size_t)l * NPROJ * D, T, NPROJ, D}; pg8::StaticOrder S; S.init(T, NPROJ, D, G, bx);
                pg8::EpiProj E{proj};
                pg8::gemm_phase<pg8::EpiProj, pg8::StaticOrder, false>(ring, g, S, E, tid);
            } else if (k == 1) {
                const int r = lane & 15, q = lane >> 4;
                for (int item = vcu; item < BATCH * NGRP; item += G) {
                    const int b = item / NGRP, g = item % NGRP, lg = l * NGRP + g;
#pragma unroll
                    for (int pz = 0; pz < 2; ++pz) __builtin_amdgcn_global_load_lds((const unsigned*)((const char*)(WgT + (size_t)lg * 2 * GC * 256) + (wave + 8 * pz) * 1024 + lane * 16), (LAS unsigned*)(ring + 116736 + (wave + 8 * pz) * 1024), 16, 0, 0);
                    const bf16* pu = proj + (size_t)2 * T * 512 + (size_t)(b * NGRP + g) * SEQ * GC;
                    {
                        const bf16* Wl = WS5 + (size_t)lg * 256 * 384; const bf16* Bl = B16 + (size_t)lg * 128 * 256;
                        LAS float* wsl = (LAS float*)ring;
                        LAS unsigned char* CB = ring + 4096 + wave * 8704;
                        const unsigned voU = (unsigned)(r * 256 + 8 * q) * 2u, voF = (unsigned)lane * 16u;
                        bf16x8 uf[2][8];
#pragma unroll
                        for (int mt = 0; mt < 2; ++mt)
#pragma unroll
                            for (int ks = 0; ks < 8; ++ks) uf[mt][ks] = ldg<bf16x8>(pu + (32 * wave + 16 * mt) * 256 + 32 * ks, voU);
                        f32x4 eS[2][8];
#pragma unroll
                        for (int mt = 0; mt < 2; ++mt)
#pragma unroll
                            for (int nt = 0; nt < 8; ++nt) eS[mt][nt] = (f32x4){0.f, 0.f, 0.f, 0.f};
                        LAS unsigned char* BI = ring + 4096;
                        LAS unsigned char* WB = ring + 4096 + 69632;
#pragma unroll
                        for (int i = 0; i < 8; ++i) __builtin_amdgcn_global_load_lds((const unsigned*)((const char*)(Bl + (8 * wave + i) * 512) + voF), (LAS unsigned*)(BI + (8 * wave + i) * 1024), 16, 0, 0);
                        if (wave < 5) __builtin_amdgcn_global_load_lds((const unsigned*)((const char*)(Wl + wave * 512) + voF), (LAS unsigned*)(WB + wave * 1024), 16, 0, 0);
                        __syncthreads();
#pragma unroll
                        for (int nt = 0; nt < 8; ++nt)
#pragma unroll
                            for (int ks = 0; ks < 8; ks += 4) { bf16x8 bv[4];
#pragma unroll
                                for (int i = 0; i < 4; ++i) bv[i] = *(const LAS bf16x8*)(BI + (nt * 8 + ks + i) * 1024 + voF);
#pragma unroll
                                for (int i = 0; i < 4; ++i) { eS[0][nt] = __builtin_amdgcn_mfma_f32_16x16x32_bf16(uf[0][ks + i], bv[i], eS[0][nt], 0, 0, 0); eS[1][nt] = __builtin_amdgcn_mfma_f32_16x16x32_bf16(uf[1][ks + i], bv[i], eS[1][nt], 0, 0, 0); } }
                        float exr[2][4], exi[2][4], t0r[4], t0i[4];
                        f32x2_t a16v[4];
#pragma unroll
                        for (int s = 0; s < 4; ++s) a16v[s] = *(const f32x2_t*)(a16t + (size_t)(lg * NST + 16 * s + r) * 2);
#pragma unroll
                        for (int s = 0; s < 4; ++s) {
                            const float p1r = a16v[s][0], p1i = a16v[s][1];
                            const float p2r = p1r * p1r - p1i * p1i, p2i = (p1r + p1r) * p1i, p4r = p2r * p2r - p2i * p2i, p4i = (p2r + p2r) * p2i, p8r = p4r * p4r - p4i * p4i, p8i = (p4r + p4r) * p4i, p16r = p8r * p8r - p8i * p8i, p16i = (p8r + p8r) * p8i;
                            float wtr = 0.f, wti = 0.f;
#pragma unroll
                            for (int mt = 0; mt < 2; ++mt) {
                                float sr = eS[mt][s][0], si = eS[mt][s + 4][0];
#pragma unroll
                                for (int jj = 1; jj < 4; ++jj) { const float nr = p1r * sr - p1i * si + eS[mt][s][jj], ni = p1r * si + p1i * sr + eS[mt][s + 4][jj]; sr = nr; si = ni; eS[mt][s][jj] = sr; eS[mt][s + 4][jj] = si; }
                                float ir = sr, ii = si;
                                { const float nr = lane_get(ir, lane - 16), ni = lane_get(ii, lane - 16); if (q >= 1) { ir += p4r * nr - p4i * ni; ii += p4r * ni + p4i * nr; } }
                                { const float nr = lane_get(ir, lane - 32), ni = lane_get(ii, lane - 32); if (q >= 2) { ir += p8r * nr - p8i * ni; ii += p8r * ni + p8i * nr; } }
                                float er = lane_get(ir, lane - 16), ei = lane_get(ii, lane - 16); if (q == 0) { er = 0.f; ei = 0.f; }
                                exr[mt][s] = er; exi[mt][s] = ei;
                                const float ttr = lane_get(ir, 48 + r), tti = lane_get(ii, 48 + r);
                                if (mt == 0) { t0r[s] = ttr; t0i[s] = tti; wtr = ttr; wti = tti; } else { const float nr = p16r * wtr - p16i * wti + ttr, ni = p16r * wti + p16i * wtr + tti; wtr = nr; wti = ni; }
                            }
                            if (q == 0) { wsl[(wave * NST + 16 * s + r) * 2] = wtr; wsl[(wave * NST + 16 * s + r) * 2 + 1] = wti; }
                        }
                        __syncthreads();
#pragma unroll
                        for (int s = 0; s < 4; ++s) {
                            const float p1r = a16v[s][0], p1i = a16v[s][1];
                            const float p2r = p1r * p1r - p1i * p1i, p2i = (p1r + p1r) * p1i, p3r = p2r * p1r - p2i * p1i, p3i = p2r * p1i + p2i * p1r, p4r = p2r * p2r - p2i * p2i, p4i = (p2r + p2r) * p2i;
                            const float p8r = p4r * p4r - p4i * p4i, p8i = (p4r + p4r) * p4i, p12r = p8r * p4r - p8i * p4i, p12i = p8r * p4i + p8i * p4r, p16r = p8r * p8r - p8i * p8i, p16i = (p8r + p8r) * p8i, p32r = p16r * p16r - p16i * p16i, p32i = (p16r + p16r) * p16i;
                            float cr = 0.f, ci = 0.f;
                            for (int w2 = 0; w2 < wave; ++w2) { const float tr = wsl[(w2 * NST + 16 * s + r) * 2], ti = wsl[(w2 * NST + 16 * s + r) * 2 + 1]; const float nr = p32r * cr - p32i * ci + tr, ni = p32r * ci + p32i * cr + ti; cr = nr; ci = ni; }
                            const float pqr = (q == 0) ? 1.f : (q == 1) ? p4r : (q == 2) ? p8r : p12r, pqi = (q == 0) ? 0.f : (q == 1) ? p4i : (q == 2) ? p8i : p12i;
#pragma unroll
                            for (int mt = 0; mt < 2; ++mt) {
                                if (mt == 1) { const float nr = p16r * cr - p16i * ci + t0r[s], ni = p16r * ci + p16i * cr + t0i[s]; cr = nr; ci = ni; }
                                const float rsr = exr[mt][s] + pqr * cr - pqi * ci, rsi = exi[mt][s] + pqr * ci + pqi * cr;
                                const float c1r = p1r * rsr - p1i * rsi + eS[mt][s][0], c1i = p1r * rsi + p1i * rsr + eS[mt][s + 4][0];
                                const float c2r = p2r * rsr - p2i * rsi + eS[mt][s][1], c2i = p2r * rsi + p2i * rsr + eS[mt][s + 4][1];
                                const float c3r = p3r * rsr - p3i * rsi + eS[mt][s][2], c3i = p3r * rsi + p3i * rsr + eS[mt][s + 4][2];
                                LAS unsigned char* cp = CB + (16 * mt + 4 * q) * 272 + 64 * s + 4 * r;
                                *(LAS unsigned*)(cp) = pk2(rsr, rsi); *(LAS unsigned*)(cp + 272) = pk2(c1r, c1i); *(LAS unsigned*)(cp + 544) = pk2(c2r, c2i); *(LAS unsigned*)(cp + 816) = pk2(c3r, c3i);
                            }
                        }
                        CBAR();
#pragma unroll
                        for (int mt = 0; mt < 2; ++mt)
#pragma unroll
                            for (int ks = 0; ks < 8; ++ks) { unsigned vo2 = voU; asm volatile("" : "+v"(vo2)); uf[mt][ks] = ldg<bf16x8>(pu + (32 * wave + 16 * mt) * 256 + 32 * ks, vo2); }
                        bf16x8 cf[2][4];
#pragma unroll
                        for (int mt = 0; mt < 2; ++mt)
#pragma unroll
                            for (int kc = 0; kc < 4; ++kc) cf[mt][kc] = *(const LAS bf16x8*)(CB + (16 * mt + r) * 272 + (32 * kc + 8 * q) * 2);
                        const unsigned voY = (unsigned)(16 * r * DSSM + 4 * q) * 2u;
#pragma unroll
                        for (int nt = 0; nt < 16; ++nt) {
                            LAS unsigned char* wb = WB + (nt & 1) * 12288;
                            if (nt + 1 < 16) { const int nf = 5 + ((nt + 1) >> 1);
                                if (wave < nf) __builtin_amdgcn_global_load_lds((const unsigned*)((const char*)(Wl + ((nt + 1) * 12 + wave) * 512) + voF), (LAS unsigned*)(WB + ((nt + 1) & 1) * 12288 + wave * 1024), 16, 0, 0);
                                if (wave + 8 < nf) __builtin_amdgcn_global_load_lds((const unsigned*)((const char*)(Wl + ((nt + 1) * 12 + wave + 8) * 512) + voF), (LAS unsigned*)(WB + ((nt + 1) & 1) * 12288 + (wave + 8) * 1024), 16, 0, 0); }
                            f32x4 y0 = {0.f, 0.f, 0.f, 0.f}, y1 = {0.f, 0.f, 0.f, 0.f};
                            bf16x8 wv[12];
#pragma unroll
                            for (int i = 0; i < 5 + (nt >> 1); ++i) wv[i] = *(const LAS bf16x8*)(wb + i * 1024 + voF);
#pragma unroll
                            for (int kc = 0; kc < 4; ++kc) { y0 = __builtin_amdgcn_mfma_f32_16x16x32_bf16(wv[kc], cf[0][kc], y0, 0, 0, 0); y1 = __builtin_amdgcn_mfma_f32_16x16x32_bf16(wv[kc], cf[1][kc], y1, 0, 0, 0); }
#pragma unroll
                            for (int ks = 0; ks <= (nt >> 1); ++ks) { y0 = __builtin_amdgcn_mfma_f32_16x16x32_bf16(wv[4 + ks], uf[0][ks], y0, 0, 0, 0); y1 = __builtin_amdgcn_mfma_f32_16x16x32_bf16(wv[4 + ks], uf[1][ks], y1, 0, 0, 0); }
                            {
                                u32x2 w0, w1; w0.x = pk2(gelu_fast(y0[0]), gelu_fast(y0[1])); w0.y = pk2(gelu_fast(y0[2]), gelu_fast(y0[3])); w1.x = pk2(gelu_fast(y1[0]), gelu_fast(y1[1])); w1.y = pk2(gelu_fast(y1[2]), gelu_fast(y1[3]));
                                stg<u32x2>(ys + (size_t)(b * SEQ + 512 * wave + nt) * DSSM + GC * g, voY, w0);
                                stg<u32x2>(ys + (size_t)(b * SEQ + 512 * wave + 256 + nt) * DSSM + GC * g, voY, w1); }
                            __syncthreads();
                        }
                    }
                    __syncthreads();
                    {
                        int lane_r = lane; asm volatile("" : "+v"(lane_r));
                        const int r = lane_r & 15, q = lane_r >> 4;
                        int g2 = g; asm volatile("" : "+s"(g2));
                        const int lgr = l * NGRP + g2, hh = g2 >> 2, qt = g2 & 3, chg = GC * g2 + r;
                        const bf16* rs = proj + (size_t)T * 512 + (size_t)(b * NH + hh) * SEQ * HD;
                        const bf16* gs = proj + (size_t)(b * NGRP + g2) * SEQ * GC;
                        LAS float* slots = (LAS float*)ring;
                        LAS unsigned char* SR = ring + 2048 + wave * 6144;
                        LAS unsigned char* GT = SR + 5040;
                        bf16x8 wg0[8], wg1[8];
#pragma unroll
                        for (int ks = 0; ks < 8; ++ks) { wg0[ks] = *(const LAS bf16x8*)(ring + 116736 + ((0 * 8 + ks) * 64 + lane_r) * 16); wg1[ks] = *(const LAS bf16x8*)(ring + 116736 + ((1 * 8 + ks) * 64 + lane_r) * 16); }
                        const float bap = gbias[(lgr * 2 + 0) * GC + r], bxp = gbias[(lgr * 2 + 1) * GC + r];
                        const float ey_ = __expf(-in_[8][l * DREC + chg]);
                        const float sp8n = -8.f * 1.4426950408889634f * ((ey_ < 0.03125f) ? ey_ * (1.f - ey_ * (0.5f - ey_ * (0.33333334f - ey_ * (0.25f - 0.2f * ey_)))) : __logf(1.f + ey_));
                        const float cw0 = in_[2][((size_t)l * 4 + 0) * DREC + chg], cw1 = in_[2][((size_t)l * 4 + 1) * DREC + chg], cw2 = in_[2][((size_t)l * 4 + 2) * DREC + chg], cw3 = in_[2][((size_t)l * 4 + 3) * DREC + chg], cbv = in_[3][l * DREC + chg];
                        float hc = 0.f;
                        const u32x4 z4u = {0u, 0u, 0u, 0u};
                        u32x4 pre[5], preg[1];
#define RG_LOAD(tbx) do { _Pragma("unroll") for (int i_ = 0; i_ < 5; ++i_) { const int p_ = lane_r + 64 * i_, row_ = p_ >> 3, t_ = (tbx) - 3 + row_; \
                                pre[i_] = (p_ < 280 && t_ >= 0) ? ldg<u32x4>(rs + ((tbx) - 3) * HD + 512 * i_, (unsigned)lane_r * 16u) : z4u; } \
                            preg[0] = ldg<u32x4>(gs + (tbx) * GC, (unsigned)lane_r * 16u); } while (0)
                        RG_LOAD(32 * wave);
                        const bool trn = (item == vcu) && (NGW == 2048);
                        LAS float* tscr = (LAS float*)(ring + 51200 + wave * 8192);
                        for (int sb = 0; sb < 16; ++sb) {
                            const int tb = 256 * sb + 32 * wave;
#pragma unroll
                            for (int i_ = 0; i_ < 5; ++i_) { const int p_ = lane_r + 64 * i_; if (p_ < 280) *(LAS u32x4*)(SR + (p_ >> 3) * 144 + 16 * (p_ & 7)) = pre[i_]; }
#pragma unroll
                            for (int i_ = 0; i_ < 1; ++i_) { const int p_ = lane_r + 64 * i_; *(LAS u32x4*)(GT + (p_ >> 1) * 32 + 16 * (p_ & 1)) = preg[i_]; }
                            CBAR();
                            if (sb < 15) RG_LOAD(tb + 256);
                            const int tj = sb * 2048 + gw; const int tlw = (tj < TRJ0) ? l + 1 : l; const bool thave = trn && tj < TRJ && tlw < DEPTH && !(tj >= TRJ1 && tj < TRJ2);
                            if (thave) { const float* tW; bf16* tWT; int tK, tN, tIL, tOFF, tK0, tN0; TR_DECODE(tlw, tj, tW, tWT, tK, tN, tIL, tOFF, tK0, tN0); TR_DMA(tscr, tW, tN, tK0, tN0); }
                            float Pb = 1.f, Hb = 0.f; float Pc[2][4], Hc[2][4];
#pragma unroll
                            for (int mt = 0; mt < 2; ++mt) {
                                f32x4 zrm = {bap, bap, bap, bap}, zim = {bxp, bxp, bxp, bxp};
#pragma unroll
                                for (int ks = 0; ks < 8; ++ks) { const bf16x8 av = *(const LAS bf16x8*)(SR + (16 * mt + r + (ks >> 1)) * 144 + (32 * (ks & 1) + 8 * q) * 2);
                                    zrm = __builtin_amdgcn_mfma_f32_16x16x32_bf16(av, wg0[ks], zrm, 0, 0, 0); zim = __builtin_amdgcn_mfma_f32_16x16x32_bf16(av, wg1[ks], zim, 0, 0, 0); }
                                float x[7];
#pragma unroll
                                for (int d = 0; d < 7; ++d) x[d] = bf2f(*(const LAS unsigned short*)(SR + (16 * mt + 4 * q + d) * 144 + (GC * qt + r) * 2));
                                float Pj = 1.f, Hj = 0.f;
#pragma unroll
                                for (int jj = 0; jj < 4; ++jj) {
                                    const float u = cbv + cw0 * x[jj] + cw1 * x[jj + 1] + cw2 * x[jj + 2] + cw3 * x[jj + 3];
                                    const float rg = __builtin_amdgcn_rcpf(1.f + __builtin_amdgcn_exp2f(zrm[jj])), ig = __builtin_amdgcn_rcpf(1.f + __builtin_amdgcn_exp2f(zim[jj]));
                                    const float av = __builtin_amdgcn_exp2f(sp8n * rg), mult = __builtin_amdgcn_sqrtf(1.f - av * av), bt = mult * (ig * u);
                                    Hj = av * Hj + bt; Pj = Pj * av; Pc[mt][jj] = Pj; Hc[mt][jj] = Hj; }
                                float Pi = Pj, Hi = Hj;
                                { const float Pn = lane_get(Pi, lane_r - 16), Hn = lane_get(Hi, lane_r - 16); if (q >= 1) { Hi = Pi * Hn + Hi; Pi = Pn * Pi; } }
                                { const float Pn = lane_get(Pi, lane_r - 32), Hn = lane_get(Hi, lane_r - 32); if (q >= 2) { Hi = Pi * Hn + Hi; Pi = Pn * Pi; } }
                                float Pe = lane_get(Pi, lane_r - 16), He = lane_get(Hi, lane_r - 16); if (q == 0) { Pe = 1.f; He = 0.f; }
                                const float Pt = lane_get(Pi, 48 + r), Ht = lane_get(Hi, 48 + r);
                                const float bP = Pb * Pe, bH = Pe * Hb + He;
#pragma unroll
                                for (int jj = 0; jj < 4; ++jj) { Hc[mt][jj] = Pc[mt][jj] * bH + Hc[mt][jj]; Pc[mt][jj] = bP * Pc[mt][jj]; }
                                Hb = Pt * Hb + Ht; Pb = Pb * Pt;
                            }
                            if (q == 0) { slots[((sb & 1) * 128 + wave * 16 + r) * 2] = Pb; slots[((sb & 1) * 128 + wave * 16 + r) * 2 + 1] = Hb; }
                            asm volatile("s_waitcnt lgkmcnt(0)" ::: "memory"); __builtin_amdgcn_s_barrier(); asm volatile("" ::: "memory");
                            float carry = hc, mine = 0.f;
#pragma unroll
                            for (int w2 = 0; w2 < 8; ++w2) { const float sp_ = slots[((sb & 1) * 128 + w2 * 16 + r) * 2], sh_ = slots[((sb & 1) * 128 + w2 * 16 + r) * 2 + 1];
                                if (w2 == wave) mine = carry; carry = sp_ * carry + sh_; }
                            hc = carry; float sst = 0.f;
                            asm volatile("s_waitcnt vmcnt(0)" ::: "memory");
#pragma unroll
                            for (int mt = 0; mt < 2; ++mt)
#pragma unroll
                                for (int jj = 0; jj < 4; ++jj) { const float h = Hc[mt][jj] + Pc[mt][jj] * mine;
                                    const float gtv = bf2f(*(const LAS unsigned short*)(GT + (16 * mt + 4 * q + jj) * 32 + 2 * r)); const float yv = gtv * h;
                                    stg<unsigned short>(ycat + (size_t)(b * SEQ + tb + 16 * mt + jj) * 1024 + GC * g2, (unsigned)(4 * q * 1024 + r) * 2u, f2bf(yv));
                                    const float sq = row16_sum(yv * yv); if (r == 4 * mt + jj) sst = sq; }
                            if (r < 8) stg<float>(ss1p + (size_t)(b * SEQ + tb) * 32 + g2, (unsigned)((16 * (r >> 2) + 4 * q + (r & 3)) * 32) * 4u, sst);
                            if (thave) {
                                const float* tW; bf16* tWT; int tK, tN, tIL, tOFF, tK0, tN0; TR_DECODE(tlw, tj, tW, tWT, tK, tN, tIL, tOFF, tK0, tN0); TR_OUT(tscr, tWT, tK, tIL, tOFF, tK0, tN0); }
                        }
#undef RG_LOAD
                    }
                    __syncthreads();
                }
            } else if (k == 2) {
                pg8::Gemm g{ys, WgluT + (size_t)l * 1024 * 512, T, 1024, 512}; pg8::StaticOrder S; S.init(T, 1024, 512, G, bx);
                pg8::EpiGated<0> E{ycat + 512, in_[18] + l * 1024, 1024, ss2p};
                pg8::gemm_phase<pg8::EpiGated<0>, pg8::StaticOrder, false>(ring, g, S, E, tid);
            } else if (k == 3) {
            } else if (k == 4) {
                pg8::Gemm g{ycat, WoutT + (size_t)l * 1024 * 1024, T, 1024, 1024}; pg8::StaticOrder S; S.init(T, 1024, 1024, G, bx);
                LAS float* st = (LAS float*)(ring + 131072);
                { pg8::Unit su;
                  for (int i = 0; i < 6 && S.next(i, su); ++i) {
                    const int row = tid >> 1, hsel = tid & 1; const size_t grow = (size_t)su.pm * 256 + row;
                    f32x4 p[8];
#pragma unroll
                    for (int j = 0; j < 8; ++j) p[j] = (hsel == 0) ? *(const f32x4*)(ss1p + grow * 32 + 4 * j) : ((j < 4) ? *(const f32x4*)(ss2p + grow * 16 + 4 * j) : (f32x4){0.f, 0.f, 0.f, 0.f});
                    float sq = 0.f;
#pragma unroll
                    for (int j = 0; j < 8; ++j) sq += (p[j][0] + p[j][1]) + (p[j][2] + p[j][3]);
                    const float rs = rsqrtf(sq * (1.f / 512.f) + RMS_EPS), ot = lane_get(rs, lane ^ 1);
                    if (hsel == 0) st[(i * 256 + row) * 2] = rs * __builtin_amdgcn_rcpf(ot); else st[(i * 256 + row) * 2 + 1] = rs;
                  }
                  __syncthreads(); }
                pg8::EpiResidRms E{xb, st};
                pg8::gemm_phase<pg8::EpiResidRms, pg8::StaticOrder, false>(ring, g, S, E, tid);
            } else if (k == 9) {
                const float* lg = in_[31] + l * D; const float* lb = in_[32] + l * D;
                const bool fin = (l == DEPTH - 1);
                f32x4 gg[2][2], bb[2][2];
#pragma unroll
                for (int j = 0; j < 2; ++j) { gg[j][0] = *(const f32x4*)(lg + 512 * j + 8 * lane); gg[j][1] = *(const f32x4*)(lg + 512 * j + 8 * lane + 4); bb[j][0] = *(const f32x4*)(lb + 512 * j + 8 * lane); bb[j][1] = *(const f32x4*)(lb + 512 * j + 8 * lane + 4); }
                u32x2 iv[4];
#pragma unroll
                for (int t = 0; t < 4; ++t) iv[t] = *(const u32x2*)(inv + 2 * (4 * gw + t));
                for (int tok0 = 4 * gw; tok0 < T; tok0 += 4 * NGW) {
                    int yr0[4], yr1[4];
#pragma unroll
                    for (int t = 0; t < 4; ++t) { yr0[t] = lc_tb[iv[t].x >> 16] * 256 + (int)(iv[t].x & 0xffffu); yr1[t] = lc_tb[iv[t].y >> 16] * 256 + (int)(iv[t].y & 0xffffu); }
                    { const int tn = (tok0 + 4 * NGW < T) ? tok0 + 4 * NGW : tok0;
#pragma unroll
                      for (int t = 0; t < 4; ++t) iv[t] = *(const u32x2*)(inv + 2 * (tn + t)); }
                    u32x4 xv[4][2], y0[4][2], y1[4][2];
#pragma unroll
                    for (int t = 0; t < 4; ++t)
#pragma unroll
                        for (int j = 0; j < 2; ++j) { xv[t][j] = *(const u32x4*)(xb + (size_t)(tok0 + t) * D + 512 * j + 8 * lane);
                            y0[t][j] = *(const u32x4*)(Yb + (size_t)yr0[t] * D + 512 * j + 8 * lane); y1[t][j] = *(const u32x4*)(Yb + (size_t)yr1[t] * D + 512 * j + 8 * lane); }
#pragma unroll
                    for (int t = 0; t < 4; ++t) { const int tok = tok0 + t;
                        float v[16]; float s = 0.f;
#pragma unroll
                        for (int j = 0; j < 2; ++j)
#pragma unroll
                            for (int i = 0; i < 4; ++i) { v[8 * j + 2 * i] = ALPHA * bflo(xv[t][j][i]) + bflo(y0[t][j][i]) + bflo(y1[t][j][i]); v[8 * j + 2 * i + 1] = ALPHA * bfhi(xv[t][j][i]) + bfhi(y0[t][j][i]) + bfhi(y1[t][j][i]); }
#pragma unroll
                        for (int i = 0; i < 16; ++i) s += v[i];
                        const float mu = wave_sum(s, lane) * (1.f / D); float s2 = 0.f;
#pragma unroll
                        for (int i = 0; i < 16; ++i) { v[i] -= mu; s2 += v[i] * v[i]; }
                        const float rstd = rsqrtf(wave_sum(s2, lane) * (1.f / D) + LN_EPS);
#pragma unroll
                        for (int j = 0; j < 2; ++j) { const int c0 = 512 * j + 8 * lane; float o[8];
#pragma unroll
                            for (int i = 0; i < 4; ++i) { o[i] = v[8 * j + i] * rstd * gg[j][0][i] + bb[j][0][i]; o[4 + i] = v[8 * j + 4 + i] * rstd * gg[j][1][i] + bb[j][1][i]; }
                            if (fin) { __builtin_nontemporal_store((f32x4){o[0], o[1], o[2], o[3]}, (f32x4*)(xf + (size_t)tok * D + c0)); __builtin_nontemporal_store((f32x4){o[4], o[5], o[6], o[7]}, (f32x4*)(xf + (size_t)tok * D + c0 + 4)); }
                            else { u32x4 w; w.x = pk2(o[0], o[1]); w.y = pk2(o[2], o[3]); w.z = pk2(o[4], o[5]); w.w = pk2(o[6], o[7]); *(u32x4*)(xb + (size_t)tok * D + c0) = w; } } }
                }
            } else if (k == 6) {
            } else if (k == 5) {
                const bf16* Wr = WrT + (size_t)l * 48 * D; const float* c1v = rcst + (l * 2 + 0) * 48; const float* c0v = rcst + (l * 2 + 1) * 48;
                const float* lg = in_[22] + l * D; const float* lb = in_[23] + l * D;
                unsigned* cntg = ctl + CW_CNT + l * NE * 64;
                LAS float* lgt = (LAS float*)(ring + 98304 + wave * 4096);
                const int r = lane & 15, q = lane >> 4;
#pragma unroll
                for (int pz = 0; pz < 12; ++pz) __builtin_amdgcn_global_load_lds((const unsigned*)((const char*)Wr + (size_t)(wave + 8 * pz) * 1024 + lane * 16), (LAS unsigned*)(ring + (wave + 8 * pz) * 1024), 16, 0, 0);
                asm volatile("s_waitcnt vmcnt(0)" ::: "memory"); __syncthreads();
                for (int ch = vcu; ch < T / 128; ch += G) {
                    if (tid < 32) lc_lcnt[tid] = 0u;
                    const int tok0 = ch * 128 + wave * 16;
                    f32x4 acc[3] = {{0.f, 0.f, 0.f, 0.f}, {0.f, 0.f, 0.f, 0.f}, {0.f, 0.f, 0.f, 0.f}};
                    const bf16* ap = xb + (size_t)(tok0 + r) * D + 8 * q;
#pragma unroll 1
                    for (int k0 = 0; k0 < 32; k0 += 8) {
                        bf16x8 av[8], bv[3][8];
#pragma unroll
                        for (int i = 0; i < 8; ++i) { av[i] = *(const bf16x8*)(ap + 32 * (k0 + i));
#pragma unroll
                            for (int nt = 0; nt < 3; ++nt) bv[nt][i] = *(const LAS bf16x8*)(ring + ((nt * 32 + k0 + i) * 64 + lane) * 16); }
#pragma unroll
                        for (int i = 0; i < 8; ++i)
#pragma unroll
                            for (int nt = 0; nt < 3; ++nt) acc[nt] = __builtin_amdgcn_mfma_f32_16x16x32_bf16(av[i], bv[nt][i], acc[nt], 0, 0, 0); }
#pragma unroll
                    for (int nt = 0; nt < 3; ++nt)
#pragma unroll
                        for (int j = 0; j < 4; ++j) lgt[(4 * q + j) * 48 + 16 * nt + r] = acc[nt][j];
                    float mymu = 0.f, myrs = 0.f;
                    const f32x4 g0a = *(const f32x4*)(lg + 8 * lane), g0b = *(const f32x4*)(lg + 8 * lane + 4), g1a = *(const f32x4*)(lg + 512 + 8 * lane), g1b = *(const f32x4*)(lg + 512 + 8 * lane + 4);
                    const f32x4 b0a = *(const f32x4*)(lb + 8 * lane), b0b = *(const f32x4*)(lb + 8 * lane + 4), b1a = *(const f32x4*)(lb + 512 + 8 * lane), b1b = *(const f32x4*)(lb + 512 + 8 * lane + 4);
#pragma unroll 1
                    for (int i0 = 0; i0 < 16; i0 += 4) {
                        u32x4 xv[4][2];
#pragma unroll
                        for (int i = 0; i < 4; ++i)
#pragma unroll
                            for (int j = 0; j < 2; ++j) xv[i][j] = *(const u32x4*)(xb + (size_t)(tok0 + i0 + i) * D + 512 * j + 8 * lane);
#pragma unroll
                        for (int i = 0; i < 4; ++i) {
                            float v[16]; float s = 0.f;
#pragma unroll
                            for (int j = 0; j < 2; ++j)
#pragma unroll
                                for (int e2 = 0; e2 < 4; ++e2) { v[8 * j + 2 * e2] = bflo(xv[i][j][e2]); v[8 * j + 2 * e2 + 1] = bfhi(xv[i][j][e2]); }
#pragma unroll
                            for (int e2 = 0; e2 < 16; ++e2) s += v[e2];
                            const float mu = wave_sum(s, lane) * (1.f / D); float s2 = 0.f;
#pragma unroll
                            for (int e2 = 0; e2 < 16; ++e2) { v[e2] -= mu; s2 += v[e2] * v[e2]; }
                            const float rstd = rsqrtf(wave_sum(s2, lane) * (1.f / D) + LN_EPS);
                            if (lane == i0 + i) { mymu = mu; myrs = rstd; }
                            u32x4 w0, w1;
                            w0.x = pk2(v[0] * rstd * g0a[0] + b0a[0], v[1] * rstd * g0a[1] + b0a[1]); w0.y = pk2(v[2] * rstd * g0a[2] + b0a[2], v[3] * rstd * g0a[3] + b0a[3]);
                            w0.z = pk2(v[4] * rstd * g0b[0] + b0b[0], v[5] * rstd * g0b[1] + b0b[1]); w0.w = pk2(v[6] * rstd * g0b[2] + b0b[2], v[7] * rstd * g0b[3] + b0b[3]);
                            w1.x = pk2(v[8] * rstd * g1a[0] + b1a[0], v[9] * rstd * g1a[1] + b1a[1]); w1.y = pk2(v[10] * rstd * g1a[2] + b1a[2], v[11] * rstd * g1a[3] + b1a[3]);
                            w1.z = pk2(v[12] * rstd * g1b[0] + b1b[0], v[13] * rstd * g1b[1] + b1b[1]); w1.w = pk2(v[14] * rstd * g1b[2] + b1b[2], v[15] * rstd * g1b[3] + b1b[3]);
                            *(u32x4*)(xb + (size_t)(tok0 + i0 + i) * D + 8 * lane) = w0; *(u32x4*)(xb + (size_t)(tok0 + i0 + i) * D + 512 + 8 * lane) = w1;
                        }
                    }
                    LDS_WAIT();
                    if (lane < 16) {
                        const LAS float* row = lgt + lane * 48;
                        float gl[NEG];
#pragma unroll
                        for (int o = 0; o < NEG; ++o) gl[o] = myrs * (row[32 + o] - mymu * c1v[32 + o]) + c0v[32 + o];
                        int gi = 0; float gm = gl[0];
#pragma unroll
                        for (int o = 1; o < NEG; ++o) if (gl[o] > gm) { gm = gl[o]; gi = o; }
                        float gs = 0.f;
#pragma unroll
                        for (int o = 0; o < NEG; ++o) gs += __expf(gl[o] - gm);
                        const float gtop = __builtin_amdgcn_rcpf(gs);
                        float el[EPG];
#pragma unroll
                        for (int o = 0; o < EPG; ++o) el[o] = myrs * (row[gi * EPG + o] - mymu * c1v[gi * EPG + o]) + c0v[gi * EPG + o];
                        int i1 = 0; float m1 = el[0];
#pragma unroll
                        for (int o = 1; o < EPG; ++o) if (el[o] > m1) { m1 = el[o]; i1 = o; }
                        int i2 = 0; float m2 = -3.0e38f;
#pragma unroll
                        for (int o = 0; o < EPG; ++o) if (o != i1 && el[o] > m2) { m2 = el[o]; i2 = o; }
                        const float p2 = __expf(m2 - m1), inv = __builtin_amdgcn_rcpf(1.f + p2);
                        lc_gv[wave * 32 + lane * 2] = gtop * inv; lc_gv[wave * 32 + lane * 2 + 1] = gtop * p2 * inv;
                        lc_ent[wave * 32 + lane * 2] = gi * EPG + i1; lc_ent[wave * 32 + lane * 2 + 1] = gi * EPG + i2;
                    }
                    __syncthreads();
                    int e = 0;
                    if (tid < 256) { e = lc_ent[tid]; lc_rank[tid] = __hip_atomic_fetch_add(&lc_lcnt[e], 1u, __ATOMIC_RELAXED, __HIP_MEMORY_SCOPE_WORKGROUP); }
                    __syncthreads();
                    if (tid < 32) lc_gb[tid] = xb_add(cntg + tid * 64, lc_lcnt[tid]);
                    __syncthreads();
                    if (tid < 256) { const int w = tid >> 5, i = tid & 31; const size_t sl = (size_t)e * T + lc_gb[e] + lc_rank[tid]; list[sl] = (ch * 128 + w * 16 + (i >> 1)) * 2 + (i & 1); gate[sl] = lc_gv[tid]; inv[ch * 256 + tid] = (e << 16) | (int)(lc_gb[e] + lc_rank[tid]); }
                    __syncthreads();
                }
            } else {
                unsigned* cntg = ctl + CW_CNT + l * NE * 64;
                if (k == 7 || ph == a.ph_lo) if (tid < 64) {
                    const unsigned cnv = (tid < NE) ? xb_ld(cntg + tid * 64) : 0u; const int tl = (int)((cnv + 255u) >> 8); int inc = tl;
#pragma unroll
                    for (int o = 1; o < 32; o <<= 1) { const int nb_ = __builtin_amdgcn_ds_bpermute((tid - o) << 2, inc); if (tid >= o) inc += nb_; }
                    if (tid < NE) { lc_cn[tid] = cnv; lc_tb[tid] = inc - tl; }
                    if (tid == NE - 1) lc_tb[NE] = inc;
                }
                __syncthreads();
                const int Uall = lc_tb[NE] * 4, Rfull = Uall / G, Lo = Uall - Rfull * G; const bool qm = (Lo > 0) && (4 * Lo <= G);
                const int ulim = qm ? Rfull * G : Uall;
                if (k == 7) {
                    pg8::Gemm g{xb, WguT + (size_t)l * NE * 1024 * 1024, 0, 1024, 1024};
                    pg8::MoeOrder S{lc_tb, lc_cn, list, G, vcu, 1024, (long)1024 * 1024 * 2, (long)256 * 1024 * 2, lane, ring + 131072 + 4096, ulim};
                    pg8::EpiGated<1> E{Hb, nullptr, 512, nullptr};
                    pg8::gemm_phase<pg8::EpiGated<1>, pg8::MoeOrder, true>(ring, g, S, E, tid);
                    if (qm && vcu < 4 * Lo) { pg8::Unit qu; S.decode(Rfull * G + (vcu >> 2), qu); pg8::gemm_quarter<pg8::EpiGated<1>, pg8::MoeOrder, true>(ring, g, S, E, tid, qu, vcu & 1, (vcu >> 1) & 1); }
                } else {
                    pg8::Gemm g{Hb, WdT + (size_t)l * NE * 1024 * 512, 0, 1024, 512};
                    pg8::MoeOrder S{lc_tb, lc_cn, list, G, vcu, 512, (long)1024 * 512 * 2, (long)256 * 512 * 2, lane, nullptr, ulim};
                    pg8::EpiMoeOut E{Yb, gate, lc_cn, ring + 131072};
                    pg8::gemm_phase<pg8::EpiMoeOut, pg8::MoeOrder, false>(ring, g, S, E, tid);
                    if (qm && vcu < 4 * Lo) { pg8::Unit qu; S.decode(Rfull * G + (vcu >> 2), qu); pg8::gemm_quarter<pg8::EpiMoeOut, pg8::MoeOrder, false>(ring, g, S, E, tid, qu, vcu & 1, (vcu >> 1) & 1); }
                }
            }
        }
        if ((ph + 1 < a.ph_hi || rep + 1 < reps) && kind != 6 && kind != 3) xcd_barrier(bar, tid);
      }
    }
}

extern "C" void kernel_launch(void* const* d_in, const int* in_sizes, int n_in, void* d_out, int out_size, void* d_ws, size_t ws_size, hipStream_t stream) {
    static int grid = 0;
    if (grid == 0) {
        if (n_in != 33 || out_size != T * D || ws_size < WS_END) { fprintf(stderr, "kernel_launch: unexpected shapes n_in=%d out=%d ws=%zu need=%zu\n", n_in, out_size, ws_size, (size_t)WS_END); grid = -1; return; }
        int dev = 0, cus = 0, per_cu = 0;
        if (hipGetDevice(&dev) != hipSuccess || hipDeviceGetAttribute(&cus, hipDeviceAttributeMultiprocessorCount, dev) != hipSuccess) { grid = -1; return; }
        if (hipFuncSetAttribute((const void*)mk_fwd, hipFuncAttributeMaxDynamicSharedMemorySize, LDS_BYTES) != hipSuccess) { fprintf(stderr, "kernel_launch: hipFuncSetAttribute failed\n"); grid = -1; return; }
        if (hipOccupancyMaxActiveBlocksPerMultiprocessor(&per_cu, (const void*)mk_fwd, NTHREADS, LDS_BYTES) != hipSuccess || per_cu < 1) { fprintf(stderr, "kernel_launch: occupancy query failed (%d)\n", per_cu); (void)hipGetLastError(); grid = -1; return; }
        grid = cus;
        if (grid < 86) { fprintf(stderr, "kernel_launch: grid %d too small (the out GEMM keeps row statistics for at most 6 units per workgroup)\n", grid); grid = -1; return; }
    }
    if (grid < 0) return;
    (void)hipMemsetAsync((char*)d_ws + WS_CTL, 0, CTL_ZERO_BYTES, stream);
    Args a{};
    for (int i = 0; i < 33; ++i) a.in[i] = (const float*)d_in[i];
    a.out = (float*)d_out; a.ws = (unsigned char*)d_ws;
    a.ph_lo = 0; a.ph_hi = 1 + 10 * DEPTH; a.li = 0; a.pad = DUPMASK;
    hipLaunchKernelGGL(mk_fwd, dim3(grid), dim3(NTHREADS), LDS_BYTES, stream, a);
}
```
